# Optimizing an MI355X kernel written in HIP

```python
import jax
import jax.numpy as jnp
from jax import lax
import numpy as np

D_MODEL = 1024
BATCH = 32
SEQ = 2048
DEPTH = 4

CTX_LEN = 256
GRID_W = 64
RMS_EPS = 1e-6

MLA_HEADS = 8
MLA_Q_RANK = 256
MLA_KV_RANK = 128
MLA_NOPE = 64
MLA_ROPE = 32
MLA_V = 64
MLA_WIDTH = MLA_HEADS * MLA_V
MLA_SCALE = (MLA_NOPE + MLA_ROPE) ** -0.5
ROPE_PAIRS = MLA_ROPE // 4
ROPE_BASE = 10000.0
Q_BLOCK = 128

HG_HEADS = 8
HG_DK = 64
HG_DV = 64
HG_KWIDTH = HG_HEADS * HG_DK
HG_WIDTH = HG_HEADS * HG_DV
HG_CHUNK = 16

CV_WIDTH = 512
CV_K = 3

N_BRANCH = 3
BR_WIDTH = 512

IN_SIZES = (MLA_Q_RANK, MLA_KV_RANK, MLA_ROPE, MLA_WIDTH,
            HG_KWIDTH, HG_WIDTH, HG_KWIDTH, HG_KWIDTH, HG_WIDTH,
            CV_WIDTH, CV_WIDTH, CV_WIDTH, CV_WIDTH,
            N_BRANCH * D_MODEL)
N_IN = sum(IN_SIZES)

kernel_name = "hybrid_mla_hgrn2_shortconv_dit"


def rms_norm(x, g):
    xf = x.astype(jnp.float32)
    y = xf * lax.rsqrt(jnp.mean(xf * xf, axis=-1, keepdims=True) + RMS_EPS)
    return (y * g.astype(jnp.float32)).astype(x.dtype)


def split_columns(z):
    cuts = np.cumsum(np.array(IN_SIZES))[:-1].tolist()
    return jnp.split(z, cuts, axis=-1)


def axial_rope_tables(n_lat, dtype):
    rows = n_lat // GRID_W
    row_id = jnp.broadcast_to(jnp.arange(rows, dtype=jnp.float32)[:, None], (rows, GRID_W)).reshape(-1)
    col_id = jnp.broadcast_to(jnp.arange(GRID_W, dtype=jnp.float32)[None, :], (rows, GRID_W)).reshape(-1)
    inv_freq = jnp.power(ROPE_BASE, -jnp.arange(ROPE_PAIRS, dtype=jnp.float32) / ROPE_PAIRS)
    ang = jnp.stack([row_id[:, None] * inv_freq, col_id[:, None] * inv_freq], axis=1)
    return jnp.cos(ang)[:, None].astype(dtype), jnp.sin(ang)[:, None].astype(dtype)


def apply_axial_rope(x, cos, sin):
    xs = x.reshape(x.shape[:-1] + (2, 2, ROPE_PAIRS))
    x1, x2 = xs[..., 0, :], xs[..., 1, :]
    rot = jnp.stack([x1 * cos - x2 * sin, x1 * sin + x2 * cos], axis=-2)
    return rot.reshape(x.shape)


def mla_attend(q_nope, q_rope, k_nope, k_rope, v):
    s = jnp.einsum('bqhd,bkhd->bhqk', q_nope, k_nope) + jnp.einsum('bqhr,bkr->bhqk', q_rope, k_rope)
    p = jax.nn.softmax(s.astype(jnp.float32) * MLA_SCALE, axis=-1).astype(v.dtype)
    return jnp.einsum('bhqk,bkhd->bqhd', p, v)


def mla_branch(cq, ckv, kr, q_norm_g, kv_norm_g, w_uq, w_ukv, n_ctx, with_ctx):
    bsz, n_tok, _ = cq.shape
    n_lat = n_tok - n_ctx
    q = (rms_norm(cq, q_norm_g) @ w_uq).reshape(bsz, n_tok, MLA_HEADS, MLA_NOPE + MLA_ROPE)
    kv = (rms_norm(ckv, kv_norm_g) @ w_ukv).reshape(bsz, n_tok, MLA_HEADS, MLA_NOPE + MLA_V)
    q_nope, q_rope = q[..., :MLA_NOPE], q[..., MLA_NOPE:]
    k_nope, v = kv[..., :MLA_NOPE], kv[..., MLA_NOPE:]
    cos, sin = axial_rope_tables(n_lat, q.dtype)
    q_rope_lat = apply_axial_rope(q_rope[:, n_ctx:], cos, sin)
    k_rope = jnp.concatenate([kr[:, :n_ctx], apply_axial_rope(kr[:, n_ctx:, None], cos, sin)[:, :, 0]], axis=1)
    n_blk = n_lat // Q_BLOCK
    qn_blk = q_nope[:, n_ctx:].reshape(bsz, n_blk, Q_BLOCK, MLA_HEADS, MLA_NOPE).swapaxes(0, 1)
    qr_blk = q_rope_lat.reshape(bsz, n_blk, Q_BLOCK, MLA_HEADS, MLA_ROPE).swapaxes(0, 1)
    o_lat = lax.map(lambda qs: mla_attend(qs[0], qs[1], k_nope, k_rope, v), (qn_blk, qr_blk))
    o_lat = o_lat.swapaxes(0, 1).reshape(bsz, n_lat, MLA_WIDTH)
    if not with_ctx:
        return o_lat
    o_ctx = mla_attend(q_nope[:, :n_ctx], q_rope[:, :n_ctx], k_nope[:, :n_ctx], k_rope[:, :n_ctx], v[:, :n_ctx])
    return jnp.concatenate([o_ctx.reshape(bsz, n_ctx, MLA_WIDTH), o_lat], axis=1)


def chunked_gated_scan(q, k, v, log_f, s0):
    bsz, n_tok, heads, _ = q.shape
    n_chunk = n_tok // HG_CHUNK
    to_chunks = lambda a: a.reshape(bsz, n_chunk, HG_CHUNK, heads, a.shape[-1]).transpose(1, 0, 3, 2, 4)
    mask = jnp.tril(jnp.ones((HG_CHUNK, HG_CHUNK), dtype=bool))

    def step(s, inp):
        qc, kc, vc, gc = inp
        b = jnp.cumsum(gc, axis=-2)
        b_last = b[..., -1:, :]
        q_dec = qc * jnp.exp(b)
        k_dec = kc * jnp.exp(-b)
        a = jnp.where(mask, jnp.einsum('bhtd,bhsd->bhts', q_dec, k_dec), 0.0)
        o = jnp.einsum('bhts,bhsv->bhtv', a, vc) + jnp.einsum('bhtd,bhdv->bhtv', q_dec, s)
        s_new = jnp.exp(b_last[..., 0, :])[..., None] * s + jnp.einsum('bhsd,bhsv->bhdv', kc * jnp.exp(b_last - b), vc)
        return s_new, o

    s_fin, o = lax.scan(step, s0, (to_chunks(q), to_chunks(k), to_chunks(v), to_chunks(log_f)))
    return o.transpose(1, 0, 3, 2, 4).reshape(bsz, n_tok, heads, v.shape[-1]), s_fin


def hgrn2_branch(q, i, f_fwd, f_bwd, lb, norm_g, n_ctx):
    bsz, n_tok, _ = q.shape
    heads = lambda a, d: a.astype(jnp.float32).reshape(bsz, n_tok, HG_HEADS, d)
    qh, vh = heads(q, HG_DK), heads(i, HG_DV)
    s0 = jnp.zeros((bsz, HG_HEADS, HG_DK, HG_DV), jnp.float32)

    def gates(f_logit, lb_d):
        z = heads(f_logit, HG_DK)
        lb_h = lb_d.reshape(HG_HEADS, HG_DK)
        log_f = jnp.logaddexp(jnp.log(lb_h), jnp.log1p(-lb_h) + jax.nn.log_sigmoid(z))
        k = (1.0 - lb_h) * jax.nn.sigmoid(-z)
        return k, log_f

    k_f, g_f = gates(f_fwd, lb[0])
    o_fwd, _ = chunked_gated_scan(qh, k_f, vh, g_f, s0)
    flip = lambda a: jnp.concatenate([jnp.flip(a[:, :n_ctx], axis=1), jnp.flip(a[:, n_ctx:], axis=1)], axis=1)
    k_b, g_b = gates(f_bwd, lb[1])
    o_bwd, _ = chunked_gated_scan(flip(qh), flip(k_b), flip(vh), flip(g_b), s0)
    o = o_fwd + flip(o_bwd)
    o = rms_norm(o, norm_g.reshape(HG_HEADS, HG_DV))
    return o.reshape(bsz, n_tok, HG_WIDTH).astype(q.dtype)


def short_conv(u, w, b):
    up = jnp.pad(u, ((0, 0), (1, 1), (0, 0)))
    return up[:, :-2] * w[0] + up[:, 1:-1] * w[1] + up[:, 2:] * w[2] + b


def conv_branch(xin, bg, cg, w, b, n_ctx, with_ctx):
    u = cg * xin
    y_lat = bg[:, n_ctx:] * short_conv(u[:, n_ctx:], w, b)
    if not with_ctx:
        return y_lat
    y_ctx = bg[:, :n_ctx] * short_conv(u[:, :n_ctx], w, b)
    return jnp.concatenate([y_ctx, y_lat], axis=1)


def setup_inputs(seed: int = 0) -> dict:
    key = jax.random.key(seed)
    ks = jax.random.split(key, 19)
    nrm = lambda k, shape, s: jax.random.normal(k, shape, jnp.float32) * s
    return {
        "x": nrm(ks[0], (BATCH, SEQ, D_MODEL), 1.0),
        "c": nrm(ks[1], (BATCH, D_MODEL), 1.0),
        "ctx": nrm(ks[2], (BATCH, CTX_LEN, D_MODEL), 1.0),
        "c_ctx": nrm(ks[3], (D_MODEL,), 1.0),
        "ada_w": nrm(ks[4], (DEPTH, D_MODEL, 3 * D_MODEL), 0.5 * D_MODEL ** -0.5),
        "ada_b": nrm(ks[5], (DEPTH, 3 * D_MODEL), 0.02),
        "norm_g": 1.0 + nrm(ks[6], (DEPTH, D_MODEL), 0.02),
        "w_in": nrm(ks[7], (DEPTH, D_MODEL, N_IN), D_MODEL ** -0.5),
        "mla_q_norm_g": 1.0 + nrm(ks[8], (DEPTH, MLA_Q_RANK), 0.02),
        "mla_kv_norm_g": 1.0 + nrm(ks[9], (DEPTH, MLA_KV_RANK), 0.02),
        "mla_w_uq": nrm(ks[10], (DEPTH, MLA_Q_RANK, MLA_HEADS * (MLA_NOPE + MLA_ROPE)), MLA_Q_RANK ** -0.5),
        "mla_w_ukv": nrm(ks[11], (DEPTH, MLA_KV_RANK, MLA_HEADS * (MLA_NOPE + MLA_V)), MLA_KV_RANK ** -0.5),
        "hg_lb_logits": nrm(ks[12], (DEPTH, 2, HG_KWIDTH), 0.5),
        "hg_norm_g": 1.0 + nrm(ks[13], (DEPTH, HG_WIDTH), 0.02),
        "conv_w": nrm(ks[14], (DEPTH, CV_K, CV_WIDTH), CV_K ** -0.5),
        "conv_b": nrm(ks[15], (DEPTH, CV_WIDTH), 0.02),
        "w_branch": nrm(ks[16], (DEPTH, N_BRANCH, BR_WIDTH, D_MODEL), BR_WIDTH ** -0.5),
        "w_out": nrm(ks[17], (DEPTH, D_MODEL, D_MODEL), D_MODEL ** -0.5),
        "final_norm_g": 1.0 + nrm(ks[18], (D_MODEL,), 0.02),
    }


def reference(x, c, ctx, c_ctx, ada_w, ada_b, norm_g, w_in, mla_q_norm_g, mla_kv_norm_g, mla_w_uq, mla_w_ukv,
              hg_lb_logits, hg_norm_g, conv_w, conv_b, w_branch, w_out, final_norm_g):
    n_ctx = ctx.shape[1]
    n_lat = x.shape[1]
    lb_all = jnp.cumsum(jax.nn.softmax(hg_lb_logits.astype(jnp.float32), axis=0), axis=0)
    lb_all = lb_all - lb_all[0:1]
    silu_c = jax.nn.silu(c)
    silu_cc = jax.nn.silu(c_ctx)
    h_lat, h_ctx = x, ctx
    for l in range(DEPTH):
        last = l == DEPTH - 1
        lo = n_ctx if last else 0
        mod = silu_c @ ada_w[l] + ada_b[l]
        mod_c = silu_cc @ ada_w[l] + ada_b[l]
        shift, scale, gate = jnp.split(mod[:, None, :], 3, axis=-1)
        shift_c, scale_c, gate_c = jnp.split(mod_c, 3, axis=-1)
        u = jnp.concatenate([rms_norm(h_ctx, norm_g[l]) * (1.0 + scale_c) + shift_c,
                             rms_norm(h_lat, norm_g[l]) * (1.0 + scale) + shift], axis=1)
        z = u @ w_in[l]
        (cq, ckv, kr, g_mla, hq, hi, hf_fwd, hf_bwd, g_hg, cx, cb, cc, g_cv, br_gate) = split_columns(z)
        y_mla = mla_branch(cq, ckv, kr, mla_q_norm_g[l], mla_kv_norm_g[l], mla_w_uq[l], mla_w_ukv[l],
                           n_ctx, not last) * jax.nn.silu(g_mla[:, lo:])
        y_hg = hgrn2_branch(hq, hi, hf_fwd, hf_bwd, lb_all[l], hg_norm_g[l], n_ctx)[:, lo:] * jax.nn.silu(g_hg[:, lo:])
        y_cv = conv_branch(cx, cb, cc, conv_w[l], conv_b[l], n_ctx, not last) * jax.nn.silu(g_cv[:, lo:])
        br_gate = jax.nn.sigmoid(br_gate[:, lo:])
        merged = (br_gate[..., :D_MODEL] * (y_mla @ w_branch[l, 0])
                  + br_gate[..., D_MODEL:2 * D_MODEL] * (y_hg @ w_branch[l, 1])
                  + br_gate[..., 2 * D_MODEL:] * (y_cv @ w_branch[l, 2]))
        out = merged @ w_out[l]
        h_lat = h_lat + gate * out[:, n_ctx - lo:]
        if not last:
            h_ctx = h_ctx + gate_c * out[:, :n_ctx]
    return rms_norm(h_lat, final_norm_g)
```

```cpp
#include <hip/hip_runtime.h>
#include <hip/hip_bf16.h>
#include <hip/hip_cooperative_groups.h>
#include <cstdio>
#ifndef PROBE
#define PROBE 0
#endif
namespace cg = cooperative_groups;

typedef unsigned short u16;
using bf16x8 = __attribute__((ext_vector_type(8))) short;
using f32x4 = __attribute__((ext_vector_type(4))) float;
using u32x4 = __attribute__((ext_vector_type(4))) unsigned;
#define DEV __device__ __forceinline__

constexpr int D = 1024, NB = 32, SEQ = 2048, NCTX = 256, NTOK = 2304, DEPTH = 4;
constexpr int NIN = 8608, NINP = 8704;
constexpr int G = 8, NGRP = NB / G, TG = G * NTOK;
constexpr int NSEG = 36;
constexpr int C_CQ = 0, C_CKV = 256, C_KR = 384, C_GMLA = 416, C_HQ = 928, C_HI = 1440, C_HF = 1952,
              C_GHG = 2976, C_CX = 3488, C_CB = 4000, C_CC = 4512, C_GCV = 5024, C_BRG = 5536;
constexpr float QSCALE = 0.10206207261596575f * 1.4426950408889634f;

struct Params {
  const float *x, *c, *ctx, *c_ctx, *ada_w, *ada_b, *norm_g, *w_in, *q_norm_g, *kv_norm_g, *w_uq, *w_ukv,
      *lb_logits, *hg_norm_g, *conv_w, *conv_b, *w_branch, *w_out, *final_g;
  float* out;
  u16 *WinT, *WuqT, *WukvT, *WbrT, *WoutT;
  float *mod, *lb, *rope, *hctx;
  u16 *u, *z, *Q, *Kc, *Vt, *Y, *mg;
  float *ob, *Dseg;
  u16* Sloc;
  unsigned* bar;
};

DEV float bf2f(u16 h) { return __uint_as_float(((unsigned)h) << 16); }
DEV u16 f2bf(float f) {
  unsigned u = __float_as_uint(f);
  u += 0x7fffu + ((u >> 16) & 1u);
  return (u16)(u >> 16);
}
typedef __bf16 bf16x2_t __attribute__((ext_vector_type(2)));
typedef float f32x2_t __attribute__((ext_vector_type(2)));
DEV unsigned pack2(float a, float b) {
  f32x2_t v = {a, b};
  return __builtin_bit_cast(unsigned, __builtin_convertvector(v, bf16x2_t));
}
DEV float bflo(unsigned w) { return __uint_as_float(w << 16); }
DEV float bfhi(unsigned w) { return __uint_as_float(w & 0xffff0000u); }
DEV float rcpf(float x) { return __builtin_amdgcn_rcpf(x); }
DEV float ex2(float x) { return __builtin_amdgcn_exp2f(x); }
DEV float sigm(float x) { return rcpf(1.f + ex2(x * -1.4426950408889634f)); }
DEV float siluf(float x) { return x * sigm(x); }
DEV float shx(float v, int mask, int lane) {
  return __builtin_bit_cast(float, __builtin_amdgcn_ds_bpermute((lane ^ mask) << 2, __builtin_bit_cast(int, v)));
}
DEV float wsum(float v, int lane) {
#pragma unroll
  for (int m = 32; m >= 1; m >>= 1) v += shx(v, m, lane);
  return v;
}

template <int ROWS>
DEV void stage_tile(const u16* __restrict__ gbase, long ld, int k0, char* lds, int tid) {
#pragma unroll
  for (int i = 0; i < ROWS / 64; ++i) {
    int idx = i * 512 + tid;
    int r = idx >> 3, s = idx & 7;
    int c = s ^ ((r >> 1) & 7);
    const u16* g = gbase + (long)r * ld + k0 + c * 8;
    __builtin_amdgcn_global_load_lds((const unsigned*)g, (unsigned*)(lds + idx * 16), 16, 0, 0);
  }
  if ((ROWS % 64) != 0 && tid < (ROWS % 64) * 8) {
    int idx = (ROWS / 64) * 512 + tid;
    int r = idx >> 3, s = idx & 7;
    int c = s ^ ((r >> 1) & 7);
    const u16* g = gbase + (long)r * ld + k0 + c * 8;
    __builtin_amdgcn_global_load_lds((const unsigned*)g, (unsigned*)(lds + idx * 16), 16, 0, 0);
  }
}
DEV bf16x8 lds_frag(const char* tile, int row, int chunk) {
  return *(const bf16x8*)(tile + row * 128 + ((chunk ^ ((row >> 1) & 7)) << 4));
}

template <int WN, int WT>
DEV void gemm_mainloop(const u16* __restrict__ Wt, long ldw, const u16* __restrict__ A, long lda, int K,
                       char* smem, int tid, f32x4 (&acc)[WN][WT]) {
  constexpr int NR = WN * 64, TR = WT * 32;
  constexpr int WB = NR * 128, STG = (NR + TR) * 128;
  constexpr int NLD = (NR + TR) / 64;
  static_assert(3 * STG <= 147456, "LDS stages");
  const int wid = tid >> 6, lane = tid & 63, fr = lane & 15, fq = lane >> 4, wn = wid & 3, wt = wid >> 2;
  const int nk = K >> 6;
  __syncthreads();
  stage_tile<NR>(Wt, ldw, 0, smem, tid);
  stage_tile<TR>(A, lda, 0, smem + WB, tid);
  if (nk > 1) {
    stage_tile<NR>(Wt, ldw, 64, smem + STG, tid);
    stage_tile<TR>(A, lda, 64, smem + STG + WB, tid);
  }
  int cur = 0;
#pragma nounroll
  for (int kt = 0; kt < nk; ++kt) {
    if (kt + 1 < nk) asm volatile("s_waitcnt vmcnt(%0)" ::"n"(NLD) : "memory");
    else asm volatile("s_waitcnt vmcnt(0)" ::: "memory");
    __builtin_amdgcn_s_barrier();
    asm volatile("" ::: "memory");
    if (kt + 2 < nk) {
      int nx = cur + 2;
      if (nx >= 3) nx -= 3;
      char* nbuf = smem + nx * STG;
      stage_tile<NR>(Wt, ldw, (kt + 2) * 64, nbuf, tid);
      stage_tile<TR>(A, lda, (kt + 2) * 64, nbuf + WB, tid);
    }
    const char* wb = smem + cur * STG;
    const char* ab = wb + WB;
#pragma unroll
    for (int ks = 0; ks < 2; ++ks) {
      bf16x8 wf[WN], af[WT];
#pragma unroll
      for (int n = 0; n < WN; ++n) wf[n] = lds_frag(wb, wn * (WN * 16) + n * 16 + fr, ks * 4 + fq);
#pragma unroll
      for (int t = 0; t < WT; ++t) af[t] = lds_frag(ab, wt * (WT * 16) + t * 16 + fr, ks * 4 + fq);
#pragma unroll
      for (int n = 0; n < WN; ++n)
#pragma unroll
        for (int t = 0; t < WT; ++t)
          acc[n][t] = __builtin_amdgcn_mfma_f32_16x16x32_bf16(wf[n], af[t], acc[n][t], 0, 0, 0);
    }
    cur = (cur == 2) ? 0 : cur + 1;
  }
}

template <int WN, int WT>
DEV void zero_acc(f32x4 (&acc)[WN][WT]) {
#pragma unroll
  for (int n = 0; n < WN; ++n)
#pragma unroll
    for (int t = 0; t < WT; ++t) acc[n][t] = f32x4{0.f, 0.f, 0.f, 0.f};
}


DEV int g8_lds_byte(int r, int c) {
  int st = (r >> 4) * 2 + (c >> 5), rr = r & 15, cc = c & 31, ob = rr * 64 + cc * 2;
  return st * 1024 + (ob ^ (((ob >> 9) & 1) << 5));
}
DEV void g8_stage_rc(int b, int& R, int& C) {
  int st = b / 1024, sb = b % 1024, swz = sb ^ (((sb >> 9) & 1) << 5);
  R = (st >> 1) * 16 + swz / 64;
  C = (st & 1) * 32 + (swz % 64) / 2;
}
template <int K, bool PRE>
DEV void gemm8_tile(const u16* __restrict__ A, const u16* __restrict__ Bt, char* smem, const int tid,
                    f32x4 (&acc)[2][2][4][2]) {
  constexpr int BK = 64, HALF = 128, HT = HALF * BK;
  u16* shm = (u16*)smem;
#define SA(b, h) (shm + ((b)*2 + (h)) * HT)
#define SB(b, h) (shm + (4 + (b)*2 + (h)) * HT)
#define STAGE(P, BASE, br, kt)                                                                         \
  do {                                                                                                 \
    long _g = (long)(br)*K + (long)(kt)*BK;                                                            \
    for (int _i = 0; _i < 2; ++_i) {                                                                   \
      int _b = tid * 16 + _i * 8192;                                                                   \
      int _r, _c;                                                                                      \
      g8_stage_rc(_b, _r, _c);                                                                         \
      __builtin_amdgcn_global_load_lds((const unsigned*)(BASE + _g + (long)_r * K + _c),               \
                                       (unsigned*)((char*)(P) + _b), 16, 0, 0);                        \
    }                                                                                                  \
  } while (0)
#define LDA(dst, b, h)                                                                                 \
  for (int m = 0; m < 4; ++m)                                                                          \
    for (int k = 0; k < 2; ++k)                                                                        \
      dst[m][k] = *reinterpret_cast<const bf16x8*>((char*)SA(b, h) + g8_lds_byte(wr * 64 + m * 16 + fr, k * 32 + fq * 8))
#define LDB(dst, b, h)                                                                                 \
  for (int n = 0; n < 2; ++n)                                                                          \
    for (int k = 0; k < 2; ++k)                                                                        \
      dst[n][k] = *reinterpret_cast<const bf16x8*>((char*)SB(b, h) + g8_lds_byte(wc * 32 + n * 16 + fr, k * 32 + fq * 8))
#define MMA(ai, bj, At_, Bt_)                                                                          \
  do {                                                                                                 \
    __builtin_amdgcn_s_setprio(1);                                                                     \
    for (int m = 0; m < 4; ++m)                                                                        \
      for (int n = 0; n < 2; ++n)                                                                      \
        for (int k = 0; k < 2; ++k)                                                                    \
          acc[ai][bj][m][n] = __builtin_amdgcn_mfma_f32_16x16x32_bf16(At_[m][k], Bt_[n][k], acc[ai][bj][m][n], 0, 0, 0); \
    __builtin_amdgcn_s_setprio(0);                                                                     \
  } while (0)
#define WAIT_V(n) asm volatile("s_waitcnt vmcnt(" #n ")" ::: "memory")
#define WAIT_L(n) asm volatile("s_waitcnt lgkmcnt(" #n ")" ::: "memory")
#define BAR __builtin_amdgcn_s_barrier()
#define SCHED __builtin_amdgcn_sched_barrier(0)
  const int wid = tid >> 6, lane = tid & 63, wr = wid >> 2, wc = wid & 3, fr = lane & 15, fq = lane >> 4;
  const int brow = 0, bcol = 0;
  bf16x8 At[4][2], B0[2][2], B1[2][2];
  const int nt = K / BK;
  if (!PRE) {
    STAGE(SB(0, 0), Bt, bcol, 0); STAGE(SA(0, 0), A, brow, 0);
    STAGE(SB(0, 1), Bt, bcol + HALF, 0); STAGE(SA(0, 1), A, brow + HALF, 0);
  }
  if (wr == 1) BAR;
  if (PRE) WAIT_V(0); else WAIT_V(4);
  BAR;
  STAGE(SB(1, 0), Bt, bcol, 1); STAGE(SA(1, 0), A, brow, 1); STAGE(SB(1, 1), Bt, bcol + HALF, 1);
  WAIT_V(6); BAR;
#pragma nounroll
  for (int t = 0; t < nt - 2; t += 2) {
    LDB(B0, 0, 0); SCHED; LDA(At, 0, 0); STAGE(SA(1, 1), A, brow + HALF, t + 1);
    WAIT_L(8); BAR; WAIT_L(0); MMA(0, 0, At, B0); BAR; SCHED;
    LDB(B1, 0, 1); STAGE(SB(0, 0), Bt, bcol, t + 2);
    BAR; WAIT_L(0); MMA(0, 1, At, B1); BAR;
    LDA(At, 0, 1); STAGE(SA(0, 0), A, brow, t + 2);
    BAR; WAIT_L(0); MMA(1, 0, At, B0); BAR; SCHED;
    STAGE(SB(0, 1), Bt, bcol + HALF, t + 2);
    WAIT_V(6); BAR; MMA(1, 1, At, B1); BAR;
    LDB(B0, 1, 0); SCHED; LDA(At, 1, 0); STAGE(SA(0, 1), A, brow + HALF, t + 2);
    WAIT_L(8); BAR; WAIT_L(0); MMA(0, 0, At, B0); BAR; SCHED;
    LDB(B1, 1, 1); STAGE(SB(1, 0), Bt, bcol, t + 3);
    BAR; WAIT_L(0); MMA(0, 1, At, B1); BAR;
    LDA(At, 1, 1); STAGE(SA(1, 0), A, brow, t + 3);
    BAR; WAIT_L(0); MMA(1, 0, At, B0); BAR; SCHED;
    STAGE(SB(1, 1), Bt, bcol + HALF, t + 3);
    WAIT_V(6); BAR; MMA(1, 1, At, B1); BAR;
  }
  { LDB(B0, 0, 0); LDA(At, 0, 0); STAGE(SA(1, 1), A, brow + HALF, nt - 1);
    BAR; WAIT_L(0); MMA(0, 0, At, B0); BAR;
    LDB(B1, 0, 1); BAR; WAIT_L(0); MMA(0, 1, At, B1); BAR;
    LDA(At, 0, 1); WAIT_V(4); BAR; WAIT_L(0); MMA(1, 0, At, B0); MMA(1, 1, At, B1); BAR; }
  { LDB(B0, 1, 0); LDA(At, 1, 0); WAIT_V(2); BAR; WAIT_L(0); MMA(0, 0, At, B0); BAR;
    LDB(B1, 1, 1); WAIT_V(0); BAR; WAIT_L(0); MMA(0, 1, At, B1); BAR;
    LDA(At, 1, 1); BAR; WAIT_L(0); MMA(1, 0, At, B0); MMA(1, 1, At, B1); BAR; }
  if (wr == 0) BAR;
#undef SA
#undef SB
#undef STAGE
#undef LDA
#undef LDB
#undef MMA
#undef WAIT_V
#undef WAIT_L
#undef BAR
#undef SCHED
}


template <int K>
DEV void gemm8_prefetch(const u16* __restrict__ A, const u16* __restrict__ Bt, char* smem, const int tid) {
  constexpr int HT = 128 * 64;
  u16* shm = (u16*)smem;
  const u16* bases[4] = {Bt, A, Bt + (long)128 * K, A + (long)128 * K};
  const int slots[4] = {4, 0, 5, 1};
#pragma unroll
  for (int q = 0; q < 4; ++q)
#pragma unroll
    for (int i = 0; i < 2; ++i) {
      int b = tid * 16 + i * 8192, r, c;
      g8_stage_rc(b, r, c);
      __builtin_amdgcn_global_load_lds((const unsigned*)(bases[q] + (long)r * K + c), (unsigned*)((char*)(shm + slots[q] * HT) + b), 16, 0, 0);
    }
}

DEV void transpose_item(const float* __restrict__ src, int N, int K, u16* __restrict__ dst,
                        const float* __restrict__ gain, int tn, int tk, char* smem, int tid) {
  float* tile = (float*)smem;
  __syncthreads();
#pragma unroll
  for (int i = 0; i < 2; ++i) {
    int kk = (tid >> 4) + 32 * i, n4 = (tid & 15) * 4;
    int k = tk * 64 + kk, n = tn * 64 + n4;
    float4 v = make_float4(0.f, 0.f, 0.f, 0.f);
    if (n < N) v = *(const float4*)(src + (long)k * N + n);
    float gsc = gain ? gain[k] : 1.f;
    tile[kk * 65 + n4 + 0] = v.x * gsc;
    tile[kk * 65 + n4 + 1] = v.y * gsc;
    tile[kk * 65 + n4 + 2] = v.z * gsc;
    tile[kk * 65 + n4 + 3] = v.w * gsc;
  }
  __syncthreads();
  int n = tid >> 3, kc = (tid & 7) * 8;
  uint4 o;
  o.x = pack2(tile[(kc + 0) * 65 + n], tile[(kc + 1) * 65 + n]);
  o.y = pack2(tile[(kc + 2) * 65 + n], tile[(kc + 3) * 65 + n]);
  o.z = pack2(tile[(kc + 4) * 65 + n], tile[(kc + 5) * 65 + n]);
  o.w = pack2(tile[(kc + 6) * 65 + n], tile[(kc + 7) * 65 + n]);
  *(uint4*)(dst + (long)(tn * 64 + n) * K + tk * 64 + kc) = o;
}

constexpr int PRE_T_IN = DEPTH * 136 * 16;
constexpr int PRE_T_UQ = DEPTH * 12 * 4;
constexpr int PRE_T_UKV = DEPTH * 16 * 2;
constexpr int PRE_T_BR = DEPTH * 3 * 16 * 8;
constexpr int PRE_T_OUT = DEPTH * 16 * 16;
constexpr int PRE_MOD = DEPTH * 48;
constexpr int PRE_ITEMS = PRE_MOD + 1 + PRE_T_IN + PRE_T_UQ + PRE_T_UKV + PRE_T_BR + PRE_T_OUT;

DEV void mod_item(const Params& p, int it, char* smem, int tid) {
  const int l = it / 48, c0 = (it % 48) * 64;
  float* sl = (float*)smem;
  const int c = tid & 63, ks = tid >> 6;
  float acc[33];
#pragma unroll
  for (int r = 0; r < 33; ++r) acc[r] = 0.f;
  for (int half = 0; half < 2; ++half) {
    __syncthreads();
    for (int e = tid; e < 33 * 512; e += 512) {
      int r = e >> 9, kk = e & 511;
      float v = (r < 32) ? p.c[r * 1024 + half * 512 + kk] : p.c_ctx[half * 512 + kk];
      sl[e] = v / (1.f + expf(-v));
    }
    __syncthreads();
    const float* wp = p.ada_w + ((long)l * 1024 + half * 512 + ks * 64) * 3072 + c0 + c;
    for (int kk = 0; kk < 64; ++kk) {
      float w = wp[(long)kk * 3072];
      const float* sp = sl + ks * 64 + kk;
#pragma unroll
      for (int r = 0; r < 33; ++r) acc[r] = fmaf(sp[r * 512], w, acc[r]);
    }
  }
  __syncthreads();
  float* red = (float*)smem;
#pragma unroll
  for (int r = 0; r < 33; ++r) red[(ks * 33 + r) * 64 + c] = acc[r];
  __syncthreads();
  for (int e = tid; e < 33 * 64; e += 512) {
    int r = e >> 6, cc = e & 63;
    float s = 0.f;
#pragma unroll
    for (int k = 0; k < 8; ++k) s += red[(k * 33 + r) * 64 + cc];
    p.mod[((long)l * 33 + r) * 3072 + c0 + cc] = s + p.ada_b[l * 3072 + c0 + cc];
  }
}

DEV void misc_item(const Params& p, int tid) {
  for (int e = tid; e < 1024; e += 512) {
    float lg[4], mx = -1e30f;
#pragma unroll
    for (int l = 0; l < 4; ++l) { lg[l] = p.lb_logits[l * 1024 + e]; mx = fmaxf(mx, lg[l]); }
    float sum = 0.f;
#pragma unroll
    for (int l = 0; l < 4; ++l) { lg[l] = expf(lg[l] - mx); sum += lg[l]; }
    float cum0 = lg[0] / sum, cum = cum0;
    p.lb[e] = 0.f;
#pragma unroll
    for (int l = 1; l < 4; ++l) { cum += lg[l] / sum; p.lb[l * 1024 + e] = cum - cum0; }
  }
  for (int e = tid; e < 512; e += 512) {
    int pos = e >> 3, pr = e & 7;
    float inv = powf(10000.f, -(float)pr / 8.f);
    float ang = (float)pos * inv;
    p.rope[e * 2] = cosf(ang);
    p.rope[e * 2 + 1] = sinf(ang);
  }
}

DEV void pre_item(const Params& p, int it, char* smem, int tid) {
  if (it < PRE_MOD) { mod_item(p, it, smem, tid); return; }
  it -= PRE_MOD;
  if (it < 1) { misc_item(p, tid); return; }
  it -= 1;
  if (it < PRE_T_IN) {
    int l = it / 2176, r = it % 2176;
    transpose_item(p.w_in + (long)l * 1024 * NIN, NIN, 1024, p.WinT + (long)l * NINP * 1024, nullptr, r / 16, r % 16, smem, tid);
    return;
  }
  it -= PRE_T_IN;
  if (it < PRE_T_UQ) {
    int l = it / 48, r = it % 48;
    transpose_item(p.w_uq + (long)l * 256 * 768, 768, 256, p.WuqT + (long)l * 768 * 256, p.q_norm_g + l * 256, r / 4, r % 4, smem, tid);
    return;
  }
  it -= PRE_T_UQ;
  if (it < PRE_T_UKV) {
    int l = it / 32, r = it % 32;
    transpose_item(p.w_ukv + (long)l * 128 * 1024, 1024, 128, p.WukvT + (long)l * 1024 * 128, p.kv_norm_g + l * 128, r / 2, r % 2, smem, tid);
    return;
  }
  it -= PRE_T_UKV;
  if (it < PRE_T_BR) {
    int m = it / 128, r = it % 128;
    transpose_item(p.w_branch + (long)m * 512 * 1024, 1024, 512, p.WbrT + (long)m * 1024 * 512, nullptr, r / 8, r % 8, smem, tid);
    return;
  }
  it -= PRE_T_BR;
  {
    int l = it / 256, r = it % 256;
    transpose_item(p.w_out + (long)l * 1024 * 1024, 1024, 1024, p.WoutT + (long)l * 1024 * 1024, nullptr, r / 16, r % 16, smem, tid);
  }
}

DEV void norm_item(const Params& p, int l, int g, int item, int tid) {
  const int wid = tid >> 6, lane = tid & 63;
  const int r = item * 8 + wid;
  const int bl = r / NTOK, j = r % NTOK, b = g * G + bl;
  const float* src;
  int mrow;
  if (j < NCTX) {
    src = (l == 0 ? p.ctx : p.hctx) + ((long)b * NCTX + j) * D;
    mrow = 32;
  } else {
    src = (l == 0 ? p.x : p.out) + ((long)b * SEQ + (j - NCTX)) * D;
    mrow = b;
  }
  const float* md = p.mod + ((long)l * 33 + mrow) * 3072;
  const float* ng = p.norm_g + l * D;
  float4 v[4];
  float ss = 0.f;
#pragma unroll
  for (int i = 0; i < 4; ++i) {
    v[i] = *(const float4*)(src + i * 256 + lane * 4);
    ss += v[i].x * v[i].x + v[i].y * v[i].y + v[i].z * v[i].z + v[i].w * v[i].w;
  }
  ss = wsum(ss, lane);
  const float rstd = rsqrtf(ss * (1.f / D) + 1e-6f);
#pragma unroll
  for (int i = 0; i < 4; ++i) {
    int col = i * 256 + lane * 4;
    float4 gg = *(const float4*)(ng + col);
    float4 sh = *(const float4*)(md + col);
    float4 sc = *(const float4*)(md + 1024 + col);
    uint2 o;
    o.x = pack2(v[i].x * rstd * gg.x * (1.f + sc.x) + sh.x, v[i].y * rstd * gg.y * (1.f + sc.y) + sh.y);
    o.y = pack2(v[i].z * rstd * gg.z * (1.f + sc.z) + sh.z, v[i].w * rstd * gg.w * (1.f + sc.w) + sh.w);
    *(uint2*)(p.u + (long)r * D + col) = o;
  }
}

DEV void final_norm_item(const Params& p, int g, int item, int tid) {
  const int wid = tid >> 6, lane = tid & 63;
  const int r = item * 8 + wid;
  float* row = p.out + ((long)g * G * SEQ + r) * D;
  float4 v[4];
  float ss = 0.f;
#pragma unroll
  for (int i = 0; i < 4; ++i) {
    v[i] = *(const float4*)(row + i * 256 + lane * 4);
    ss += v[i].x * v[i].x + v[i].y * v[i].y + v[i].z * v[i].z + v[i].w * v[i].w;
  }
  ss = wsum(ss, lane);
  const float rstd = rsqrtf(ss * (1.f / D) + 1e-6f);
#pragma unroll
  for (int i = 0; i < 4; ++i) {
    int col = i * 256 + lane * 4;
    float4 gg = *(const float4*)(p.final_g + col);
    float4 o = make_float4(v[i].x * rstd * gg.x, v[i].y * rstd * gg.y, v[i].z * rstd * gg.z, v[i].w * rstd * gg.w);
    *(float4*)(row + col) = o;
  }
}

DEV int colkind(int f) {
  if (f < C_GMLA) return 0;
  if (f < C_HQ) return 1;
  if (f < C_HF) return 0;
  if (f < C_HF + 512) return 3;
  if (f < C_GHG) return 4;
  if (f < C_CX) return 1;
  if (f < C_GCV) return 0;
  if (f < C_BRG) return 1;
  if (f < NIN) return 2;
  return 5;
}

DEV void inproj_item(const Params& p, int l, int tt, int tf, int ntt, int ntf, char* smem, int tid) {
  const int t0 = tt * 256, f0 = tf * 256;
  f32x4 acc[2][2][4][2];
#pragma unroll
  for (int a = 0; a < 2; ++a)
#pragma unroll
    for (int b = 0; b < 2; ++b)
#pragma unroll
      for (int m = 0; m < 4; ++m)
#pragma unroll
        for (int n = 0; n < 2; ++n) acc[a][b][m][n] = f32x4{0.f, 0.f, 0.f, 0.f};
  gemm8_tile<1024, true>(p.WinT + ((long)l * NINP + f0) * 1024, p.u + (long)t0 * 1024, smem, tid, acc);
  if (ntt >= 0) gemm8_prefetch<1024>(p.WinT + ((long)l * NINP + ntf * 256) * 1024, p.u + (long)ntt * 256 * 1024, smem, tid);
  const int wid = tid >> 6, lane = tid & 63, fr = lane & 15, fq = lane >> 4, wr = wid >> 2, wc = wid & 3;
#pragma unroll
  for (int ai = 0; ai < 2; ++ai)
#pragma unroll
    for (int m = 0; m < 4; ++m) {
      const int fb = f0 + ai * 128 + wr * 64 + m * 16;
      const int kind = colkind(fb);
      if (kind == 5) continue;
      const int f = fb + fq * 4;
      float4 lbv = make_float4(0.f, 0.f, 0.f, 0.f);
      if (kind == 3) lbv = *(const float4*)(p.lb + l * 1024 + (f - C_HF));
      if (kind == 4) lbv = *(const float4*)(p.lb + l * 1024 + 512 + (f - C_HF - 512));
#pragma unroll
      for (int bj = 0; bj < 2; ++bj)
#pragma unroll
        for (int n = 0; n < 2; ++n) {
          const int r = t0 + bj * 128 + wc * 32 + n * 16 + fr;
          const f32x4 a = acc[ai][bj][m][n];
          float o0, o1, o2, o3;
          if (kind == 0) { o0 = a[0]; o1 = a[1]; o2 = a[2]; o3 = a[3]; }
          else if (kind == 1) { o0 = siluf(a[0]); o1 = siluf(a[1]); o2 = siluf(a[2]); o3 = siluf(a[3]); }
          else if (kind == 2) { o0 = sigm(a[0]); o1 = sigm(a[1]); o2 = sigm(a[2]); o3 = sigm(a[3]); }
          else {
            o0 = (1.f - lbv.x) * sigm(-a[0]); o1 = (1.f - lbv.y) * sigm(-a[1]);
            o2 = (1.f - lbv.z) * sigm(-a[2]); o3 = (1.f - lbv.w) * sigm(-a[3]);
          }
          uint2 o;
          o.x = pack2(o0, o1);
          o.y = pack2(o2, o3);
          *(uint2*)(p.z + (long)r * NINP + f) = o;
        }
    }
}

DEV void row_scales(const u16* __restrict__ zrow0, int col0, int ncol, float* rs, int tid, int nrows = 192) {
  if (tid >= nrows * 2) return;
  const int r = tid >> 1, h = tid & 1, lane = tid & 63;
  const u16* s = zrow0 + (long)r * NINP + col0 + h * (ncol / 2);
  float ss = 0.f;
  for (int i = 0; i < ncol / 2; i += 8) {
    uint4 v = *(const uint4*)(s + i);
    ss += bflo(v.x) * bflo(v.x) + bfhi(v.x) * bfhi(v.x) + bflo(v.y) * bflo(v.y) + bfhi(v.y) * bfhi(v.y) +
          bflo(v.z) * bflo(v.z) + bfhi(v.z) * bfhi(v.z) + bflo(v.w) * bflo(v.w) + bfhi(v.w) * bfhi(v.w);
  }
  ss += shx(ss, 1, lane);
  if (h == 0) rs[r] = rsqrtf(ss / (float)ncol + 1e-6f);
}

template <int WT>
DEV void qproj_item(const Params& p, int l, int t0, int tf, char* smem, int tid) {
  const int f0 = tf * 128;
  f32x4 acc[2][WT];
  zero_acc<2, WT>(acc);
  float* rs = (float*)(smem + 122880);
  __syncthreads();
  row_scales(p.z + (long)t0 * NINP, C_CQ, 256, rs, tid, WT * 32);
  gemm_mainloop<2, WT>(p.WuqT + ((long)l * 768 + f0) * 256, 256, p.z + (long)t0 * NINP + C_CQ, NINP, 256, smem, tid, acc);
  const int wid = tid >> 6, lane = tid & 63, fr = lane & 15, fq = lane >> 4, wn = wid & 3, wt = wid >> 2;
  const int bl = t0 / NTOK, j0 = t0 % NTOK;
#pragma unroll
  for (int n = 0; n < 2; ++n) {
    const int fb = f0 + wn * 32 + n * 16;
    const int head = fb / 96, part = (fb % 96) >> 4;
    const int dd = part * 16 + fq * 4;
#pragma unroll
    for (int t = 0; t < WT; ++t) {
      const int tl = wt * (WT * 16) + t * 16 + fr;
      const int j = j0 + tl;
      const float sc = rs[tl];
      float v0 = acc[n][t][0] * sc, v1 = acc[n][t][1] * sc, v2 = acc[n][t][2] * sc, v3 = acc[n][t][3] * sc;
      if (part >= 4) {
        float p0 = shx(v0, 32, lane), p1 = shx(v1, 32, lane), p2 = shx(v2, 32, lane), p3 = shx(v3, 32, lane);
        if (j >= NCTX) {
          const int tq = j - NCTX;
          const int pos = (part == 4) ? (tq >> 6) : (tq & 63);
          const float* rp = p.rope + (pos * 8 + (fq & 1) * 4) * 2;
          float4 cs01 = *(const float4*)rp, cs23 = *(const float4*)(rp + 4);
          if ((fq >> 1) == 0) {
            v0 = v0 * cs01.x - p0 * cs01.y; v1 = v1 * cs01.z - p1 * cs01.w;
            v2 = v2 * cs23.x - p2 * cs23.y; v3 = v3 * cs23.z - p3 * cs23.w;
          } else {
            v0 = p0 * cs01.y + v0 * cs01.x; v1 = p1 * cs01.w + v1 * cs01.z;
            v2 = p2 * cs23.y + v2 * cs23.x; v3 = p3 * cs23.w + v3 * cs23.z;
          }
        }
      }
      uint2 o;
      o.x = pack2(v0 * QSCALE, v1 * QSCALE);
      o.y = pack2(v2 * QSCALE, v3 * QSCALE);
      *(uint2*)(p.Q + ((long)(bl * 8 + head) * NTOK + j) * 96 + dd) = o;
      asm volatile("" ::: "memory");
    }
  }
}

DEV void kvproj_item(const Params& p, int l, int tt, int tf, char* smem, int tid) {
  const int t0 = tt * 192, f0 = tf * 128;
  f32x4 acc[2][6];
  zero_acc<2, 6>(acc);
  float* rs = (float*)(smem + 122880);
  __syncthreads();
  row_scales(p.z + (long)t0 * NINP, C_CKV, 128, rs, tid);
  gemm_mainloop<2, 6>(p.WukvT + ((long)l * 1024 + f0) * 128, 128, p.z + (long)t0 * NINP + C_CKV, NINP, 128, smem, tid, acc);
  const int wid = tid >> 6, lane = tid & 63, fr = lane & 15, fq = lane >> 4, wn = wid & 3, wt = wid >> 2;
  const int bl = t0 / NTOK, j0 = t0 % NTOK;
#pragma unroll
  for (int n = 0; n < 2; ++n) {
    const int fb = f0 + wn * 32 + n * 16;
    const int head = fb >> 7, dd = (fb & 127) + fq * 4;
#pragma unroll
    for (int t = 0; t < 6; ++t) {
      const int tl = wt * 96 + t * 16 + fr;
      const int j = j0 + tl;
      const float sc = rs[tl];
      float v0 = acc[n][t][0] * sc, v1 = acc[n][t][1] * sc, v2 = acc[n][t][2] * sc, v3 = acc[n][t][3] * sc;
      if (dd < 64) {
        uint2 o;
        o.x = pack2(v0, v1);
        o.y = pack2(v2, v3);
        *(uint2*)(p.Kc + ((long)(bl * 8 + head) * NTOK + j) * 96 + dd) = o;
      } else {
        u16* vp = p.Vt + ((long)(bl * 8 + head) * 64 + (dd - 64)) * NTOK + j;
        vp[0] = f2bf(v0);
        vp[NTOK] = f2bf(v1);
        vp[2 * NTOK] = f2bf(v2);
        vp[3 * NTOK] = f2bf(v3);
      }
    }
  }
}

DEV void krope_item(const Params& p, int item, int tid) {
  const int r = item * 256 + (tid >> 1), axis = tid & 1;
  const int bl = r / NTOK, j = r % NTOK;
  const u16* s = p.z + (long)r * NINP + C_KR + axis * 16;
  uint4 a = *(const uint4*)s, b = *(const uint4*)(s + 8);
  float x1[8] = {bflo(a.x), bfhi(a.x), bflo(a.y), bfhi(a.y), bflo(a.z), bfhi(a.z), bflo(a.w), bfhi(a.w)};
  float x2[8] = {bflo(b.x), bfhi(b.x), bflo(b.y), bfhi(b.y), bflo(b.z), bfhi(b.z), bflo(b.w), bfhi(b.w)};
  if (j >= NCTX) {
    const int tq = j - NCTX;
    const int pos = axis == 0 ? (tq >> 6) : (tq & 63);
    const float* rp = p.rope + pos * 16;
#pragma unroll
    for (int i = 0; i < 8; ++i) {
      float c = rp[i * 2], sn = rp[i * 2 + 1];
      float y1 = x1[i] * c - x2[i] * sn, y2 = x1[i] * sn + x2[i] * c;
      x1[i] = y1;
      x2[i] = y2;
    }
  }
  uint4 oa, ob;
  oa.x = pack2(x1[0], x1[1]); oa.y = pack2(x1[2], x1[3]); oa.z = pack2(x1[4], x1[5]); oa.w = pack2(x1[6], x1[7]);
  ob.x = pack2(x2[0], x2[1]); ob.y = pack2(x2[2], x2[3]); ob.z = pack2(x2[4], x2[5]); ob.w = pack2(x2[6], x2[7]);
#pragma unroll
  for (int h = 0; h < 8; ++h) {
    u16* d = p.Kc + ((long)(bl * 8 + h) * NTOK + j) * 96 + 64 + axis * 16;
    *(uint4*)d = oa;
    *(uint4*)(d + 8) = ob;
  }
}

DEV void hg_combine_item(const Params& p, int item, int tid) {
  const int e = (item * 512 + tid) * 2;
  const int sc = e >> 12, el = e & 4095, d = el & 63;
  u16* base = p.Sloc + (long)sc * NSEG * 4096 + el;
  const float* db = p.Dseg + (long)sc * NSEG * 64 + d;
  unsigned vals[NSEG - 1];
  float2 dd[NSEG - 1];
#pragma unroll
  for (int k = 0; k < NSEG - 1; ++k) { vals[k] = *(const unsigned*)(base + (long)k * 4096); dd[k] = *(const float2*)(db + k * 64); }
  float s0 = bflo(vals[0]), s1 = bfhi(vals[0]);
#pragma unroll
  for (int k = 1; k < NSEG - 1; ++k) {
    s0 = fmaf(dd[k].x, s0, bflo(vals[k]));
    s1 = fmaf(dd[k].y, s1, bfhi(vals[k]));
    *(unsigned*)(base + (long)k * 4096) = pack2(s0, s1);
  }
}

constexpr int KROW = 208, VROW = 272, KBYTES = 128 * KROW, ASTG = KBYTES + 64 * VROW;

DEV void attn_item(const Params& p, int bl, int head, int q0, int nkeys, char* smem, int tid) {
  const int wid = tid >> 6, lane = tid & 63, fr = lane & 15, fq = lane >> 4;
  const long bh = bl * 8 + head;
  const u16* Qp = p.Q + (bh * NTOK + q0 + wid * 32) * 96;
  const u16* Kg = p.Kc + bh * NTOK * 96;
  const u16* Vg = p.Vt + bh * 64 * NTOK;
  bf16x8 qf[2][3];
#pragma unroll
  for (int qt = 0; qt < 2; ++qt)
#pragma unroll
    for (int ks = 0; ks < 3; ++ks) qf[qt][ks] = *(const bf16x8*)(Qp + (qt * 16 + fr) * 96 + ks * 32 + fq * 8);
  f32x4 o[4][2];
#pragma unroll
  for (int a = 0; a < 4; ++a)
#pragma unroll
    for (int b = 0; b < 2; ++b) o[a][b] = f32x4{0.f, 0.f, 0.f, 0.f};
  const int nt = nkeys >> 7;
  u32x4 kr[3], vr[2];
  int koff[3], voffg[2], voffl[2];
#pragma unroll
  for (int i = 0; i < 3; ++i) { int c = i * 512 + tid; koff[i] = (c / 12) * KROW + (c % 12) * 16; }
#pragma unroll
  for (int i = 0; i < 2; ++i) { int c = i * 512 + tid; voffg[i] = (c >> 4) * NTOK + (c & 15) * 8; voffl[i] = (c >> 4) * VROW + (c & 15) * 16; }
  __syncthreads();
#pragma unroll
  for (int i = 0; i < 3; ++i) kr[i] = *(const u32x4*)(Kg + (long)(i * 512 + tid) * 8);
#pragma unroll
  for (int i = 0; i < 2; ++i) vr[i] = *(const u32x4*)(Vg + voffg[i]);
#pragma unroll
  for (int i = 0; i < 3; ++i) *(u32x4*)(smem + koff[i]) = kr[i];
#pragma unroll
  for (int i = 0; i < 2; ++i) *(u32x4*)(smem + KBYTES + voffl[i]) = vr[i];
  __syncthreads();
  f32x4 negm[2];
  {
    f32x4 s0[8][2];
#pragma unroll
    for (int kf = 0; kf < 8; ++kf) {
      s0[kf][0] = f32x4{0.f, 0.f, 0.f, 0.f};
      s0[kf][1] = f32x4{0.f, 0.f, 0.f, 0.f};
#pragma unroll
      for (int ks = 0; ks < 3; ++ks) {
        bf16x8 a = *(const bf16x8*)(smem + (kf * 16 + fr) * KROW + ks * 64 + fq * 16);
        s0[kf][0] = __builtin_amdgcn_mfma_f32_16x16x32_bf16(a, qf[0][ks], s0[kf][0], 0, 0, 0);
        s0[kf][1] = __builtin_amdgcn_mfma_f32_16x16x32_bf16(a, qf[1][ks], s0[kf][1], 0, 0, 0);
      }
    }
#pragma unroll
    for (int qt = 0; qt < 2; ++qt) {
      float mx = -1e30f;
#pragma unroll
      for (int kf = 0; kf < 8; ++kf) mx = fmaxf(fmaxf(fmaxf(s0[kf][qt][0], s0[kf][qt][1]), fmaxf(s0[kf][qt][2], s0[kf][qt][3])), mx);
      mx = fmaxf(mx, shx(mx, 16, lane));
      mx = fmaxf(mx, shx(mx, 32, lane));
      negm[qt] = f32x4{-mx, -mx, -mx, -mx};
    }
  }
  f32x4 lacc[2] = {f32x4{0.f, 0.f, 0.f, 0.f}, f32x4{0.f, 0.f, 0.f, 0.f}};
  const bf16x8 ones = {0x3F80, 0x3F80, 0x3F80, 0x3F80, 0x3F80, 0x3F80, 0x3F80, 0x3F80};
  for (int t = 0; t < nt; ++t) {
    if (t + 1 < nt) {
#pragma unroll
      for (int i = 0; i < 3; ++i) kr[i] = *(const u32x4*)(Kg + (long)(t + 1) * 128 * 96 + (long)(i * 512 + tid) * 8);
#pragma unroll
      for (int i = 0; i < 2; ++i) vr[i] = *(const u32x4*)(Vg + (t + 1) * 128 + voffg[i]);
    }
    const char* kb = smem + (t & 1) * ASTG;
    const char* vb = kb + KBYTES;
#pragma unroll
    for (int hh = 0; hh < 2; ++hh) {
      f32x4 s[4][2];
#pragma unroll
      for (int kf = 0; kf < 4; ++kf) {
#pragma unroll
        for (int ks = 0; ks < 3; ++ks) {
          bf16x8 a = *(const bf16x8*)(kb + (hh * 64 + kf * 16 + fr) * KROW + ks * 64 + fq * 16);
          s[kf][0] = __builtin_amdgcn_mfma_f32_16x16x32_bf16(a, qf[0][ks], ks == 0 ? negm[0] : s[kf][0], 0, 0, 0);
          s[kf][1] = __builtin_amdgcn_mfma_f32_16x16x32_bf16(a, qf[1][ks], ks == 0 ? negm[1] : s[kf][1], 0, 0, 0);
        }
      }
#pragma unroll
      for (int kk = 0; kk < 2; ++kk) {
        bf16x8 pb[2];
#pragma unroll
        for (int qt = 0; qt < 2; ++qt) {
          const float e0 = ex2(s[2 * kk][qt][0]), e1 = ex2(s[2 * kk][qt][1]), e2 = ex2(s[2 * kk][qt][2]), e3 = ex2(s[2 * kk][qt][3]);
          const float e4 = ex2(s[2 * kk + 1][qt][0]), e5 = ex2(s[2 * kk + 1][qt][1]), e6 = ex2(s[2 * kk + 1][qt][2]), e7 = ex2(s[2 * kk + 1][qt][3]);
          u32x4 cw = {pack2(e0, e1), pack2(e2, e3), pack2(e4, e5), pack2(e6, e7)};
          pb[qt] = __builtin_bit_cast(bf16x8, cw);
        }
        lacc[0] = __builtin_amdgcn_mfma_f32_16x16x32_bf16(ones, pb[0], lacc[0], 0, 0, 0);
        lacc[1] = __builtin_amdgcn_mfma_f32_16x16x32_bf16(ones, pb[1], lacc[1], 0, 0, 0);
#pragma unroll
        for (int dvf = 0; dvf < 4; ++dvf) {
          const char* vp = vb + (dvf * 16 + fr) * VROW + (hh * 64 + kk * 32 + fq * 4) * 2;
          const uint2 h0 = *(const uint2*)vp, h1 = *(const uint2*)(vp + 32);
          u32x4 vw = {h0.x, h0.y, h1.x, h1.y};
          const bf16x8 va = __builtin_bit_cast(bf16x8, vw);
          o[dvf][0] = __builtin_amdgcn_mfma_f32_16x16x32_bf16(va, pb[0], o[dvf][0], 0, 0, 0);
          o[dvf][1] = __builtin_amdgcn_mfma_f32_16x16x32_bf16(va, pb[1], o[dvf][1], 0, 0, 0);
        }
      }
    }
    if (t + 1 < nt) {
      char* nb = smem + ((t + 1) & 1) * ASTG;
#pragma unroll
      for (int i = 0; i < 3; ++i) *(u32x4*)(nb + koff[i]) = kr[i];
#pragma unroll
      for (int i = 0; i < 2; ++i) *(u32x4*)(nb + KBYTES + voffl[i]) = vr[i];
    }
    __syncthreads();
  }
#pragma unroll
  for (int qt = 0; qt < 2; ++qt) {
    const float linv = rcpf(lacc[qt][0]);
    const int j = q0 + wid * 32 + qt * 16 + fr;
    const long r = (long)bl * NTOK + j;
#pragma unroll
    for (int dvf = 0; dvf < 4; ++dvf) {
      const int col = head * 64 + dvf * 16 + fq * 4;
      uint2 gz = *(const uint2*)(p.z + r * NINP + C_GMLA + col);
      uint2 ov;
      ov.x = pack2(o[dvf][qt][0] * linv * bflo(gz.x), o[dvf][qt][1] * linv * bfhi(gz.x));
      ov.y = pack2(o[dvf][qt][2] * linv * bflo(gz.y), o[dvf][qt][3] * linv * bfhi(gz.y));
      *(uint2*)(p.Y + r * 512 + col) = ov;
    }
  }
}

DEV void conv_item(const Params& p, int l, int item, int tid) {
  const int tok0 = item * 16;
  const int bl = tok0 / NTOK, jt = tok0 % NTOK;
  const int lo = jt < NCTX ? 0 : NCTX, hi = jt < NCTX ? NCTX : NTOK;
  const int ch0 = (tid & 63) * 8, tr = tid >> 6;
  const int jb = jt + tr * 2;
  const u16* zb = p.z + (long)bl * NTOK * NINP;
  uint4 xa[4], xc[4], bq[2], gq[2];
#pragma unroll
  for (int i = 0; i < 4; ++i) {
    const int j = jb - 1 + i;
    const bool ok = j >= lo && j < hi;
    const int jc = ok ? j : jb;
    xa[i] = *(const uint4*)(zb + (long)jc * NINP + C_CX + ch0);
    xc[i] = *(const uint4*)(zb + (long)jc * NINP + C_CC + ch0);
    if (!ok) xa[i] = make_uint4(0u, 0u, 0u, 0u);
  }
#pragma unroll
  for (int i = 0; i < 2; ++i) {
    bq[i] = *(const uint4*)(zb + (long)(jb + i) * NINP + C_CB + ch0);
    gq[i] = *(const uint4*)(zb + (long)(jb + i) * NINP + C_GCV + ch0);
  }
  float w0[8], w1[8], w2[8], bb[8];
#pragma unroll
  for (int i = 0; i < 8; ++i) {
    w0[i] = p.conv_w[(l * 3 + 0) * 512 + ch0 + i];
    w1[i] = p.conv_w[(l * 3 + 1) * 512 + ch0 + i];
    w2[i] = p.conv_w[(l * 3 + 2) * 512 + ch0 + i];
    bb[i] = p.conv_b[l * 512 + ch0 + i];
  }
  float u[4][8];
#pragma unroll
  for (int i = 0; i < 4; ++i) {
    u[i][0] = bflo(xa[i].x) * bflo(xc[i].x); u[i][1] = bfhi(xa[i].x) * bfhi(xc[i].x);
    u[i][2] = bflo(xa[i].y) * bflo(xc[i].y); u[i][3] = bfhi(xa[i].y) * bfhi(xc[i].y);
    u[i][4] = bflo(xa[i].z) * bflo(xc[i].z); u[i][5] = bfhi(xa[i].z) * bfhi(xc[i].z);
    u[i][6] = bflo(xa[i].w) * bflo(xc[i].w); u[i][7] = bfhi(xa[i].w) * bfhi(xc[i].w);
  }
#pragma unroll
  for (int i = 0; i < 2; ++i) {
    const uint4 b = bq[i], gg = gq[i];
    const float bv[8] = {bflo(b.x), bfhi(b.x), bflo(b.y), bfhi(b.y), bflo(b.z), bfhi(b.z), bflo(b.w), bfhi(b.w)};
    const float gv[8] = {bflo(gg.x), bfhi(gg.x), bflo(gg.y), bfhi(gg.y), bflo(gg.z), bfhi(gg.z), bflo(gg.w), bfhi(gg.w)};
    float y[8];
#pragma unroll
    for (int k = 0; k < 8; ++k) y[k] = bv[k] * (u[i][k] * w0[k] + u[i + 1][k] * w1[k] + u[i + 2][k] * w2[k] + bb[k]) * gv[k];
    uint4 ov;
    ov.x = pack2(y[0], y[1]); ov.y = pack2(y[2], y[3]); ov.z = pack2(y[4], y[5]); ov.w = pack2(y[6], y[7]);
    *(uint4*)(p.Y + ((long)2 * TG + (long)bl * NTOK + jb + i) * 512 + ch0) = ov;
  }
}

constexpr int HROW = 144;
constexpr int H_QH = 0, H_QL = 18432, H_KH = 36864, H_KL = 55296, H_VT = 73728, H_TOT = 82944, H_REF = 84992, H_XCH = 86016;

DEV void split2(float x, u16& hi, u16& lo) {
  hi = f2bf(x);
  lo = f2bf(x - bf2f(hi));
}
DEV void split_pack(float a, float b, unsigned& hi, unsigned& lo) {
  u16 ah, al, bh, bl_;
  split2(a, ah, al);
  split2(b, bh, bl_);
  hi = (unsigned)ah | ((unsigned)bh << 16);
  lo = (unsigned)al | ((unsigned)bl_ << 16);
}
#define MFMA16(a, b, c) __builtin_amdgcn_mfma_f32_16x16x32_bf16(a, b, c, 0, 0, 0)

DEV const u16* hg_zb(const Params& p, int item) {
  const int jseg = item % NSEG, bh = item / NSEG, head = bh & 7, bl = bh >> 3;
  return p.z + ((long)bl * NTOK + jseg * 64) * NINP + head * 64;
}
DEV void hg_load_k(const u16* __restrict__ zb, int tid, u16 (&kr)[16]) {
  const int wid = tid >> 6, lane = tid & 63, dir = wid >> 2, qu = wid & 3;
  const u16* kp = zb + (long)(qu * 16) * NINP + C_HF + dir * 512 + lane;
#pragma unroll
  for (int i = 0; i < 16; ++i) kr[i] = kp[(long)i * NINP];
}
DEV void hg_load_v(const u16* __restrict__ zb, int wid, int lane, u16 (&vr)[8]) {
  const u16* vp = zb + (long)(wid * 8) * NINP + C_HI + lane;
#pragma unroll
  for (int i = 0; i < 8; ++i) vr[i] = vp[(long)i * NINP];
}
DEV void hg_store_vt(int wid, int lane, char* smem, const u16 (&vr)[8]) {
  u32x4 w = {(unsigned)vr[0] | ((unsigned)vr[1] << 16), (unsigned)vr[2] | ((unsigned)vr[3] << 16),
             (unsigned)vr[4] | ((unsigned)vr[5] << 16), (unsigned)vr[6] | ((unsigned)vr[7] << 16)};
  *(u32x4*)(smem + H_VT + lane * HROW + wid * 16) = w;
}
DEV void hg_prep(int dir, int qu, int lane, char* smem, const u16 (&kr)[16], float (&g)[16], float (&kk)[16]) {
#pragma unroll
  for (int i = 0; i < 16; ++i) {
    kk[i] = bf2f(kr[i]);
    g[i] = fmaxf(__logf(1.f - kk[i]), -20.f);
  }
  float total;
  if (dir == 0) {
#pragma unroll
    for (int i = 1; i < 16; ++i) g[i] += g[i - 1];
    total = g[15];
  } else {
#pragma unroll
    for (int i = 14; i >= 0; --i) g[i] += g[i + 1];
    total = g[0];
  }
  ((float*)(smem + H_TOT))[(dir * 4 + qu) * 64 + lane] = total;
}

DEV void hg1_item(const Params& p, int item, char* smem, int tid, const u16 (&kr)[16]) {
  const int wid = tid >> 6, lane = tid & 63, fr = lane & 15, fq = lane >> 4;
  const int jseg = item % NSEG, bh = item / NSEG, head = bh & 7, bl = bh >> 3;
  const int dir = wid >> 2, qu = wid & 3;
  const long row0 = (long)bl * NTOK + jseg * 64;
  const u16* zb = p.z + row0 * NINP + head * 64;
  u16 vr[8];
  hg_load_v(zb, wid, lane, vr);
  float g[16], kk[16];
  __syncthreads();
  hg_prep(dir, qu, lane, smem, kr, g, kk);
  __syncthreads();
  hg_store_vt(wid, lane, smem, vr);
  const float* tot = (const float*)(smem + H_TOT) + dir * 256 + lane;
  const float t0 = tot[0], t1 = tot[64], t2 = tot[128], t3 = tot[192];
  const float T = (t0 + t1) + (t2 + t3);
  float off;
  if (dir == 0) off = (qu > 0 ? t0 : 0.f) + (qu > 1 ? t1 : 0.f) + (qu > 2 ? t2 : 0.f);
  else off = (qu < 3 ? t3 : 0.f) + (qu < 2 ? t2 : 0.f) + (qu < 1 ? t1 : 0.f);
  unsigned wh[8], wl[8];
#pragma unroll
  for (int i = 0; i < 8; ++i)
    split_pack(kk[2 * i] * __expf(T - (g[2 * i] + off)), kk[2 * i + 1] * __expf(T - (g[2 * i + 1] + off)), wh[i], wl[i]);
  char* khT = smem + H_KH + dir * 9216 + lane * HROW + qu * 32;
  char* klT = smem + H_KL + dir * 9216 + lane * HROW + qu * 32;
  *(u32x4*)khT = u32x4{wh[0], wh[1], wh[2], wh[3]};
  *(u32x4*)(khT + 16) = u32x4{wh[4], wh[5], wh[6], wh[7]};
  *(u32x4*)klT = u32x4{wl[0], wl[1], wl[2], wl[3]};
  *(u32x4*)(klT + 16) = u32x4{wl[4], wl[5], wl[6], wl[7]};
  const int sidx = dir ? (jseg < 4 ? 3 - jseg : 39 - jseg) : jseg;
  const long slot = ((long)((bl * 8 + head) * 2 + dir)) * NSEG + sidx;
  if (qu == 0) p.Dseg[slot * 64 + lane] = __expf(T);
  __syncthreads();
  f32x4 acc[4];
#pragma unroll
  for (int vt = 0; vt < 4; ++vt) acc[vt] = f32x4{0.f, 0.f, 0.f, 0.f};
#pragma unroll
  for (int ks = 0; ks < 2; ++ks) {
    const int ao = dir * 9216 + (qu * 16 + fr) * HROW + ks * 64 + fq * 16;
    const bf16x8 ah = *(const bf16x8*)(smem + H_KH + ao);
    const bf16x8 al = *(const bf16x8*)(smem + H_KL + ao);
#pragma unroll
    for (int vt = 0; vt < 4; ++vt) {
      const bf16x8 b = *(const bf16x8*)(smem + H_VT + (vt * 16 + fr) * HROW + ks * 64 + fq * 16);
      acc[vt] = MFMA16(ah, b, acc[vt]);
      acc[vt] = MFMA16(al, b, acc[vt]);
    }
  }
  u16* so = p.Sloc + slot * 4096;
#pragma unroll
  for (int vt = 0; vt < 4; ++vt) {
    uint2 o2;
    o2.x = pack2(acc[vt][0], acc[vt][1]);
    o2.y = pack2(acc[vt][2], acc[vt][3]);
    *(uint2*)(so + (vt * 16 + fr) * 64 + qu * 16 + fq * 4) = o2;
  }
}

DEV void hg3_item(const Params& p, int l, int item, char* smem, int tid, const u16 (&kr)[16]) {
  constexpr int O_QA = 0, O_KA = 18432, O_X = 36864;
  const int wid = tid >> 6, lane = tid & 63, fr = lane & 15, fq = lane >> 4;
  const int jseg = item % NSEG, bh = item / NSEG, head = bh & 7, bl = bh >> 3;
  const int dir = wid >> 2, qu = wid & 3;
  const long row0 = (long)bl * NTOK + jseg * 64;
  const u16* zb = p.z + row0 * NINP + head * 64;
  const int sidx = dir ? (jseg < 4 ? 3 - jseg : 39 - jseg) : jseg;
  const int hf = dir == 0 ? (qu >> 1) : 1 - (qu >> 1);
  u16 vr[8], qr[16];
  hg_load_v(zb, wid, lane, vr);
  {
    const u16* qp = zb + (long)(qu * 16) * NINP + C_HQ + lane;
#pragma unroll
    for (int i = 0; i < 16; ++i) qr[i] = qp[(long)i * NINP];
  }
  u32x4 sf[2][4];
  if (sidx > 0) {
    const u16* sp = p.Sloc + (((long)((bl * 8 + head) * 2 + dir)) * NSEG + sidx - 1) * 4096;
#pragma unroll
    for (int ks = 0; ks < 2; ++ks)
#pragma unroll
      for (int vt = 0; vt < 4; ++vt) sf[ks][vt] = *(const u32x4*)(sp + (vt * 16 + fr) * 64 + ks * 32 + fq * 8);
  }
  const long rfin = row0 + qu * 16 + fr;
  uint2 gz[4];
  if (dir == 0) {
#pragma unroll
    for (int vt = 0; vt < 4; ++vt) gz[vt] = *(const uint2*)(p.z + rfin * NINP + C_GHG + head * 64 + vt * 16 + fq * 4);
  }
  float g[16], kk[16];
  __syncthreads();
  hg_prep(dir, qu, lane, smem, kr, g, kk);
  __syncthreads();
  hg_store_vt(wid, lane, smem, vr);
  {
    const float* tot = (const float*)(smem + H_TOT) + dir * 256 + lane;
    const float t0 = tot[0], t1 = tot[64], t2 = tot[128], t3 = tot[192];
    float off, mA, mA0, Bv;
    if (dir == 0) {
      off = (qu > 0 ? t0 : 0.f) + (qu > 1 ? t1 : 0.f) + (qu > 2 ? t2 : 0.f);
      mA0 = t0; Bv = t0 + t1; mA = hf ? (Bv + t2) : mA0;
    } else {
      off = (qu < 3 ? t3 : 0.f) + (qu < 2 ? t2 : 0.f) + (qu < 1 ? t1 : 0.f);
      mA0 = t3; Bv = t3 + t2; mA = hf ? (Bv + t1) : mA0;
    }
    if (qu == 0) {
      ((float*)(smem + H_REF))[dir * 128 + lane] = __expf(mA0);
      ((float*)(smem + H_REF))[dir * 128 + 64 + lane] = __expf(Bv);
    }
    const int ro = dir * 9216 + (qu * 16) * HROW + lane * 2;
#pragma unroll
    for (int i = 0; i < 16; ++i) {
      const float bb = g[i] + off;
      const float e1 = fminf(fmaxf(bb - mA, -60.f), 60.f);
      const float qv = bf2f(qr[i]);
      *(u16*)(smem + O_QA + ro + i * HROW) = f2bf(qv * __expf(e1));
      *(u16*)(smem + O_KA + ro + i * HROW) = f2bf(kk[i] * __expf(-e1));
      const float xv = hf ? qv * __expf(fminf(bb - Bv, 0.f)) : kk[i] * __expf(fminf(Bv - bb, 0.f));
      *(u16*)(smem + O_X + ro + i * HROW) = f2bf(xv);
    }
  }
  __syncthreads();
  const int tt = qu;
  bf16x8 qA[2], qB[2];
#pragma unroll
  for (int ks = 0; ks < 2; ++ks) {
    const int qo = dir * 9216 + (tt * 16 + fr) * HROW + ks * 64 + fq * 16;
    qA[ks] = *(const bf16x8*)(smem + O_QA + qo);
    qB[ks] = *(const bf16x8*)(smem + O_X + qo);
  }
  f32x4 at[4];
#pragma unroll
  for (int st = 0; st < 4; ++st) {
    at[st] = f32x4{0.f, 0.f, 0.f, 0.f};
    const bool needed = dir == 0 ? (st <= tt) : (st >= tt);
    if (needed) {
      const bool same = (st >> 1) == (tt >> 1);
#pragma unroll
      for (int ks = 0; ks < 2; ++ks) {
        const int ko = dir * 9216 + (st * 16 + fr) * HROW + ks * 64 + fq * 16;
        if (same) at[st] = MFMA16(*(const bf16x8*)(smem + O_KA + ko), qA[ks], at[st]);
        else at[st] = MFMA16(*(const bf16x8*)(smem + O_X + ko), qB[ks], at[st]);
      }
      if (st == tt) {
#pragma unroll
        for (int j = 0; j < 4; ++j) {
          const int sl = fq * 4 + j;
          const bool keep = dir == 0 ? (sl <= fr) : (sl >= fr);
          at[st][j] = keep ? at[st][j] : 0.f;
        }
      }
    }
  }
  f32x4 o[4];
#pragma unroll
  for (int vt = 0; vt < 4; ++vt) o[vt] = f32x4{0.f, 0.f, 0.f, 0.f};
#pragma unroll
  for (int k2 = 0; k2 < 2; ++k2) {
    const u32x4 cw = {pack2(at[2 * k2][0], at[2 * k2][1]), pack2(at[2 * k2][2], at[2 * k2][3]),
                      pack2(at[2 * k2 + 1][0], at[2 * k2 + 1][1]), pack2(at[2 * k2 + 1][2], at[2 * k2 + 1][3])};
    const bf16x8 pb = __builtin_bit_cast(bf16x8, cw);
#pragma unroll
    for (int vt = 0; vt < 4; ++vt) {
      const char* vp = smem + H_VT + (vt * 16 + fr) * HROW + (k2 * 32 + fq * 4) * 2;
      const uint2 h0 = *(const uint2*)vp, h1 = *(const uint2*)(vp + 32);
      const u32x4 vw = {h0.x, h0.y, h1.x, h1.y};
      o[vt] = MFMA16(__builtin_bit_cast(bf16x8, vw), pb, o[vt]);
    }
  }
  if (sidx > 0) {
    const float* rf = (const float*)(smem + H_REF) + dir * 128 + hf * 64;
#pragma unroll
    for (int ks = 0; ks < 2; ++ks) {
      const float4 e0 = *(const float4*)(rf + ks * 32 + fq * 8), e1 = *(const float4*)(rf + ks * 32 + fq * 8 + 4);
      const bf16x8 qi = hf ? qB[ks] : qA[ks];
#pragma unroll
      for (int vt = 0; vt < 4; ++vt) {
        const u32x4 sv = sf[ks][vt];
        const u32x4 sw = {pack2(bflo(sv[0]) * e0.x, bfhi(sv[0]) * e0.y), pack2(bflo(sv[1]) * e0.z, bfhi(sv[1]) * e0.w),
                          pack2(bflo(sv[2]) * e1.x, bfhi(sv[2]) * e1.y), pack2(bflo(sv[3]) * e1.z, bfhi(sv[3]) * e1.w)};
        o[vt] = MFMA16(__builtin_bit_cast(bf16x8, sw), qi, o[vt]);
      }
    }
  }
  f32x4* xch = (f32x4*)(smem + H_XCH);
  if (dir == 1) {
#pragma unroll
    for (int vt = 0; vt < 4; ++vt) xch[(tt * 4 + vt) * 64 + lane] = o[vt];
  }
  __syncthreads();
  if (dir == 0) {
    float ss = 0.f;
#pragma unroll
    for (int vt = 0; vt < 4; ++vt) {
      o[vt] += xch[(tt * 4 + vt) * 64 + lane];
      ss += o[vt][0] * o[vt][0] + o[vt][1] * o[vt][1] + o[vt][2] * o[vt][2] + o[vt][3] * o[vt][3];
    }
    ss += shx(ss, 16, lane);
    ss += shx(ss, 32, lane);
    const float rstd = rsqrtf(ss * (1.f / 64.f) + 1e-6f);
#pragma unroll
    for (int vt = 0; vt < 4; ++vt) {
      const int col = head * 64 + vt * 16 + fq * 4;
      const float4 gn = *(const float4*)(p.hg_norm_g + l * 512 + col);
      uint2 ov;
      ov.x = pack2(o[vt][0] * rstd * gn.x * bflo(gz[vt].x), o[vt][1] * rstd * gn.y * bfhi(gz[vt].x));
      ov.y = pack2(o[vt][2] * rstd * gn.z * bflo(gz[vt].y), o[vt][3] * rstd * gn.w * bfhi(gz[vt].y));
      *(uint2*)(p.Y + ((long)TG + rfin) * 512 + col) = ov;
    }
  }
}

template <int WT>
DEV void branch_item(const Params& p, int l, int t0, int tf, char* smem, int tid) {
  const int f0 = tf * 128;
  const int wid = tid >> 6, lane = tid & 63, fr = lane & 15, fq = lane >> 4, wn = wid & 3, wt = wid >> 2;
  f32x4 mg[2][WT];
  zero_acc<2, WT>(mg);
#pragma nounroll
  for (int br = 0; br < 3; ++br) {
    f32x4 acc[2][WT];
    zero_acc<2, WT>(acc);
    constexpr bool PREG = (WT <= 6);
    uint2 gzr[2][PREG ? WT : 1];
    if (PREG) {
#pragma unroll
      for (int n = 0; n < 2; ++n)
#pragma unroll
        for (int t = 0; t < (PREG ? WT : 1); ++t)
          gzr[n][t] = *(const uint2*)(p.z + (long)(t0 + wt * (WT * 16) + t * 16 + fr) * NINP + C_BRG + br * 1024 + f0 + wn * 32 + n * 16 + fq * 4);
    }
    gemm_mainloop<2, WT>(p.WbrT + ((long)(l * 3 + br) * 1024 + f0) * 512, 512, p.Y + ((long)br * TG + t0) * 512, 512, 512, smem, tid, acc);
#pragma unroll
    for (int n = 0; n < 2; ++n) {
#pragma unroll
      for (int t = 0; t < WT; ++t) {
        const uint2 gz = PREG ? gzr[n][PREG ? t : 0]
                              : *(const uint2*)(p.z + (long)(t0 + wt * (WT * 16) + t * 16 + fr) * NINP + C_BRG + br * 1024 + f0 + wn * 32 + n * 16 + fq * 4);
        mg[n][t][0] += bflo(gz.x) * acc[n][t][0];
        mg[n][t][1] += bfhi(gz.x) * acc[n][t][1];
        mg[n][t][2] += bflo(gz.y) * acc[n][t][2];
        mg[n][t][3] += bfhi(gz.y) * acc[n][t][3];
      }
    }
  }
#pragma unroll
  for (int n = 0; n < 2; ++n) {
    const int f = f0 + wn * 32 + n * 16 + fq * 4;
#pragma unroll
    for (int t = 0; t < WT; ++t) {
      const long r = t0 + wt * (WT * 16) + t * 16 + fr;
      uint2 o;
      o.x = pack2(mg[n][t][0], mg[n][t][1]);
      o.y = pack2(mg[n][t][2], mg[n][t][3]);
      *(uint2*)(p.mg + r * 1024 + f) = o;
    }
  }
}

template <int WT>
DEV void outproj_item(const Params& p, int l, int g, int t0, int tf, char* smem, int tid) {
  const int f0 = tf * 128;
  const int wid = tid >> 6, lane = tid & 63, fr = lane & 15, fq = lane >> 4, wn = wid & 3, wt = wid >> 2;
  f32x4 acc[2][WT];
  zero_acc<2, WT>(acc);
  const int bl = t0 / NTOK, j0 = t0 % NTOK, b = g * G + bl;
  const float* gate_c = p.mod + ((long)l * 33 + 32) * 3072 + 2048;
  const float* gate_l = p.mod + ((long)l * 33 + b) * 3072 + 2048;
  const float* hc = (l == 0 ? p.ctx : p.hctx) + (long)b * NCTX * D;
  const float* hl = (l == 0 ? p.x : p.out) + (long)b * SEQ * D;
  float4 hpre[2][WT];
#pragma unroll
  for (int n = 0; n < 2; ++n)
#pragma unroll
    for (int t = 0; t < WT; ++t) {
      const int f = f0 + wn * 32 + n * 16 + fq * 4;
      const int j = j0 + wt * (WT * 16) + t * 16 + fr;
      hpre[n][t] = *(const float4*)(j < NCTX ? hc + (long)j * D + f : hl + (long)(j - NCTX) * D + f);
    }
  gemm_mainloop<2, WT>(p.WoutT + ((long)l * 1024 + f0) * 1024, 1024, p.mg + (long)t0 * 1024, 1024, 1024, smem, tid, acc);
#pragma unroll
  for (int n = 0; n < 2; ++n) {
    const int f = f0 + wn * 32 + n * 16 + fq * 4;
    const float4 gc = *(const float4*)(gate_c + f), gl = *(const float4*)(gate_l + f);
#pragma unroll
    for (int t = 0; t < WT; ++t) {
      const int j = j0 + wt * (WT * 16) + t * 16 + fr;
      const bool isctx = j < NCTX;
      const float4 gt = isctx ? gc : gl;
      float* hd = isctx ? p.hctx + ((long)b * NCTX + j) * D + f : p.out + ((long)b * SEQ + (j - NCTX)) * D + f;
      float4 h = hpre[n][t];
      h.x += gt.x * acc[n][t][0];
      h.y += gt.y * acc[n][t][1];
      h.z += gt.z * acc[n][t][2];
      h.w += gt.w * acc[n][t][3];
      *(float4*)hd = h;
    }
  }
}


#define XB_TMO 128
#define XB_XCNT(j) (256 + 64 * (j))
#define XB_XSUB(j) (1280 + 64 * (j))
#define XB_XGEN(j) (2304 + 64 * (j))
#define XB_TOP 3328
#define XB_TOPGEN 3392
#define XCD_BAR_WORDS 3456
#define XB_SPIN_CAP (1u << 22)
#define LAS __attribute__((address_space(3)))
DEV unsigned xb_ld(unsigned* p) { return __hip_atomic_load(p, __ATOMIC_RELAXED, __HIP_MEMORY_SCOPE_AGENT); }
DEV unsigned xb_add(unsigned* p, unsigned v) { return __hip_atomic_fetch_add(p, v, __ATOMIC_RELAXED, __HIP_MEMORY_SCOPE_AGENT); }
DEV unsigned xb_xcc_id() { return (unsigned)__builtin_amdgcn_s_getreg((3 << 11) | 20) & 0xFu; }
#define XB_SPIN(cond, bar)                                                                   \
  do {                                                                                       \
    unsigned _sp = 0;                                                                        \
    while (cond) {                                                                           \
      __builtin_amdgcn_s_sleep(1);                                                           \
      if ((++_sp & 255u) == 0u) {                                                            \
        if (xb_ld(&(bar)[XB_TMO])) break;                                                    \
        if (_sp > XB_SPIN_CAP) { atomicAdd(&(bar)[XB_TMO], 1u); break; }                     \
      }                                                                                      \
    }                                                                                        \
  } while (0)
struct XcdBarrier {
  unsigned* bar;
  unsigned x;
  volatile LAS unsigned* st;
};
DEV XcdBarrier xcd_barrier_post(unsigned* bar, volatile LAS unsigned* st) {
  XcdBarrier b;
  b.bar = bar;
  b.x = xb_xcc_id();
  b.st = st;
  if (threadIdx.x == 0) (void)xb_add(&bar[XB_XCNT(b.x)], 1u);
  return b;
}
DEV void xcd_barrier_complete(unsigned* bar, unsigned x, unsigned& nloc, unsigned& nx) {
  const unsigned Gn = gridDim.x * gridDim.y * gridDim.z;
  unsigned sum, cnt, mine, sp = 0u;
  for (;;) {
    sum = 0u; cnt = 0u; mine = 0u;
#pragma unroll
    for (unsigned j = 0; j < 16; ++j) {
      const unsigned c = xb_ld(&bar[XB_XCNT(j)]);
      sum += c;
      cnt += (c > 0u) ? 1u : 0u;
      mine = (j == x) ? c : mine;
    }
    if (sum == Gn) break;
    __builtin_amdgcn_s_sleep(1);
    if ((++sp & 255u) == 0u) {
      if (xb_ld(&bar[XB_TMO])) break;
      if (sp > XB_SPIN_CAP) { atomicAdd(&bar[XB_TMO], 1u); break; }
    }
  }
  nloc = mine > 0u ? mine : 1u;
  nx = cnt > 0u ? cnt : 1u;
}
DEV void xcd_barrier(const XcdBarrier& b) {
  asm volatile("s_waitcnt vmcnt(0)" ::: "memory");
  __syncthreads();
  if (threadIdx.x == 0) {
    unsigned* bar = b.bar;
    __builtin_amdgcn_s_waitcnt(0);
    unsigned nloc = b.st[0], nx = b.st[1];
    if (nloc == 0u) { xcd_barrier_complete(bar, b.x, nloc, nx); b.st[0] = nloc; b.st[1] = nx; }
    const unsigned old = xb_add(&bar[XB_XSUB(b.x)], 1u);
    const unsigned gen = old / nloc;
    if (old + 1u == (gen + 1u) * nloc) {
      __builtin_amdgcn_fence(__ATOMIC_RELEASE, "agent");
      asm volatile("s_waitcnt vmcnt(0)" ::: "memory");
      const unsigned og = xb_add(&bar[XB_TOP], 1u);
      const unsigned tg = og / nx;
      if (og + 1u == (tg + 1u) * nx) xb_add(&bar[XB_TOPGEN], 1u);
      else XB_SPIN(xb_ld(&bar[XB_TOPGEN]) == tg, bar);
      __builtin_amdgcn_fence(__ATOMIC_ACQUIRE, "agent");
      xb_add(&bar[XB_XGEN(b.x)], 1u);
      asm volatile("s_waitcnt vmcnt(0)" ::: "memory");
    } else {
      XB_SPIN(xb_ld(&bar[XB_XGEN(b.x)]) == gen, bar);
      __builtin_amdgcn_fence(__ATOMIC_ACQUIRE, "agent");
      asm volatile("s_waitcnt vmcnt(0)" ::: "memory");
    }
  }
  __syncthreads();
}

#define REPS(k) for (int rp = 0; rp < ((PROBE == (k)) ? 2 : 1); ++rp)
#define GSYNC do { xcd_barrier(xb); if (PROBE == 11) xcd_barrier(xb); } while (0)
__global__ void __launch_bounds__(512) mega(Params p, int coop) {
  __shared__ __attribute__((aligned(16))) char smem[147456 + 16];
  cg::grid_group grid = cg::this_grid();
  const int tid0 = threadIdx.x, nb = gridDim.x, bid = blockIdx.x;
  const int xx = bid & 7, xr = bid >> 3, xper = nb >> 3;
  if (tid0 < 4) ((unsigned*)(smem + 147456))[tid0] = 0u;
  __syncthreads();
  XcdBarrier xb = xcd_barrier_post(p.bar, (volatile LAS unsigned*)(smem + 147456));
#define OPQ int tid = tid0; asm volatile("" : "+v"(tid));

  for (int it = bid; it < PRE_ITEMS; it += nb) { OPQ pre_item(p, it, smem, tid); }
  grid.sync();

  for (int g = 0; g < NGRP; ++g) {
    for (int l = 0; l < DEPTH; ++l) {
      const bool last = (l == DEPTH - 1);
      REPS(10) {
        for (int it = bid; it < TG / 8; it += nb) { OPQ norm_item(p, l, g, it, tid); }
        GSYNC;
      }
      REPS(1) {
        {
          const int ntile = last ? 8 * 34 + 8 : 9 * 34;
          auto tile_of = [&](int j, int& tl, int& tf) {
            if (!last) { tl = j % 9; tf = j / 9; }
            else if (j < 8 * 34) { tl = 1 + (j & 7); tf = j >> 3; }
            else { tl = 0; const int q = j - 8 * 34; tf = q == 0 ? 1 : 4 + q; }
          };
          __syncthreads();
          if (xr < ntile) {
            OPQ
            int tl, tf;
            tile_of(xr, tl, tf);
            gemm8_prefetch<1024>(p.WinT + ((long)l * NINP + tf * 256) * 1024, p.u + (long)(xx * 9 + tl) * 256 * 1024, smem, tid);
          }
          for (int j = xr; j < ntile; j += xper) {
            OPQ
            int tl, tf, ntl = 0, ntf = 0;
            tile_of(j, tl, tf);
            const int jn = j + xper;
            const bool hn = jn < ntile;
            if (hn) tile_of(jn, ntl, ntf);
            inproj_item(p, l, xx * 9 + tl, tf, hn ? xx * 9 + ntl : -1, ntf, smem, tid);
          }
        }
        GSYNC;
      }
      REPS(2) {
        {
          OPQ
          u16 kr[16];
          hg_load_k(hg_zb(p, bid), tid, kr);
          for (int it = bid; it < 2304; it += nb) {
            u16 kr2[16];
            const int nxt = (it + nb < 2304) ? it + nb : it;
            hg_load_k(hg_zb(p, nxt), tid, kr2);
            hg1_item(p, it, smem, tid, kr);
#pragma unroll
            for (int i = 0; i < 16; ++i) kr[i] = kr2[i];
          }
        }
        for (int j = xr; j < 64 + 96 + 16 + 9; j += xper) {
          OPQ
          if (j < 64) qproj_item<6>(p, l, (xx * 12 + j % 12) * 192, j / 12, smem, tid);
          else if (j < 160) kvproj_item(p, l, xx * 12 + (j - 64) % 12, (j - 64) / 12, smem, tid);
          else if (j < 176) { const int q = 64 + ((j - 160) >> 1); qproj_item<3>(p, l, (xx * 12 + q % 12) * 192 + ((j - 160) & 1) * 96, q / 12, smem, tid); }
          else krope_item(p, xx * 9 + (j - 176), tid);
        }
        GSYNC;
      }
      REPS(3) {
        for (int j = xr; j < (last ? 64 : 72); j += xper) {
          OPQ
          if (j < 64) attn_item(p, j >> 3, xx, NCTX + (j & 7) * 256, NTOK, smem, tid);
          else attn_item(p, j - 64, xx, 0, NCTX, smem, tid);
        }
        if (!rp)
          for (int it = bid; it < 512; it += nb) { OPQ hg_combine_item(p, it, tid); }
        GSYNC;
      }
      REPS(4) {
        {
          OPQ
          const int nh3 = last ? G * 8 * 32 : G * 8 * NSEG;
          auto h3map = [&](int it) { return last ? (it >> 5) * NSEG + 4 + (it & 31) : it; };
          u16 kr[16];
          hg_load_k(hg_zb(p, h3map(bid)), tid, kr);
          for (int it = bid; it < nh3; it += nb) {
            u16 kr2[16];
            const int nxt = (it + nb < nh3) ? it + nb : it;
            hg_load_k(hg_zb(p, h3map(nxt)), tid, kr2);
            hg3_item(p, l, h3map(it), smem, tid, kr);
#pragma unroll
            for (int i = 0; i < 16; ++i) kr[i] = kr2[i];
          }
        }
        for (int it = bid; it < (last ? G * (SEQ / 16) : TG / 16); it += nb) {
          OPQ
          conv_item(p, l, last ? (it >> 7) * (NTOK / 16) + (NCTX / 16) + (it & 127) : it, tid);
        }
        GSYNC;
      }
      REPS(5) {
        if (!last) {
          for (int j = xr; j < 96; j += xper) { OPQ branch_item<6>(p, l, (xx * 12 + j % 12) * 192, j / 12, smem, tid); }
        } else {
          for (int j = xr; j < 64; j += xper) { OPQ branch_item<8>(p, l, xx * NTOK + NCTX + (j & 7) * 256, j >> 3, smem, tid); }
        }
        GSYNC;
      }
      if (!last) {
        for (int j = xr; j < 96; j += xper) { OPQ outproj_item<6>(p, l, g, (xx * 12 + j % 12) * 192, j / 12, smem, tid); }
      } else {
        for (int j = xr; j < 64; j += xper) { OPQ outproj_item<8>(p, l, g, xx * NTOK + NCTX + (j & 7) * 256, j >> 3, smem, tid); }
      }
      GSYNC;
    }
    for (int it = bid; it < G * SEQ / 8; it += nb) { OPQ final_norm_item(p, g, it, tid); }
  }
}

extern "C" void kernel_launch(void* const* d_in, const int* in_sizes, int n_in, void* d_out, int out_size,
                              void* d_ws, size_t ws_size, hipStream_t stream) {
  Params p{};
  const float* const* in = (const float* const*)d_in;
  p.x = in[0]; p.c = in[1]; p.ctx = in[2]; p.c_ctx = in[3]; p.ada_w = in[4]; p.ada_b = in[5]; p.norm_g = in[6];
  p.w_in = in[7]; p.q_norm_g = in[8]; p.kv_norm_g = in[9]; p.w_uq = in[10]; p.w_ukv = in[11]; p.lb_logits = in[12];
  p.hg_norm_g = in[13]; p.conv_w = in[14]; p.conv_b = in[15]; p.w_branch = in[16]; p.w_out = in[17]; p.final_g = in[18];
  p.out = (float*)d_out;
  char* w = (char*)d_ws;
  size_t off = 0;
  auto take = [&](size_t bytes) { char* r = w + off; off += (bytes + 255) & ~(size_t)255; return r; };
  p.WinT = (u16*)take((size_t)DEPTH * NINP * 1024 * 2);
  p.WuqT = (u16*)take((size_t)DEPTH * 768 * 256 * 2);
  p.WukvT = (u16*)take((size_t)DEPTH * 1024 * 128 * 2);
  p.WbrT = (u16*)take((size_t)DEPTH * 3 * 1024 * 512 * 2);
  p.WoutT = (u16*)take((size_t)DEPTH * 1024 * 1024 * 2);
  p.mod = (float*)take((size_t)DEPTH * 33 * 3072 * 4);
  p.lb = (float*)take((size_t)DEPTH * 1024 * 4);
  p.rope = (float*)take((size_t)64 * 8 * 2 * 4);
  p.hctx = (float*)take((size_t)NB * NCTX * D * 4);
  p.u = (u16*)take((size_t)TG * D * 2);
  p.z = (u16*)take((size_t)TG * NINP * 2);
  p.Q = (u16*)take((size_t)G * 8 * NTOK * 96 * 2);
  p.Kc = (u16*)take((size_t)G * 8 * NTOK * 96 * 2);
  p.Vt = (u16*)take((size_t)G * 8 * 64 * NTOK * 2);
  p.Y = (u16*)take((size_t)3 * TG * 512 * 2);
  p.mg = (u16*)take((size_t)TG * D * 2);
  p.ob = (float*)take((size_t)TG * 512 * 4);
  p.Sloc = (u16*)take((size_t)G * 16 * NSEG * 4096 * 2);
  p.Dseg = (float*)take((size_t)G * 16 * NSEG * 64 * 4);
  p.bar = (unsigned*)take((size_t)XCD_BAR_WORDS * 4);
  if (off > ws_size) { fprintf(stderr, "workspace too small: need %zu have %zu\n", off, ws_size); return; }

  static int grid_blocks = 0;
  if (!grid_blocks) {
    int dev = 0, cus = 0, per_cu = 0;
    hipGetDevice(&dev);
    hipDeviceGetAttribute(&cus, hipDeviceAttributeMultiprocessorCount, dev);
    hipOccupancyMaxActiveBlocksPerMultiprocessor(&per_cu, mega, 512, 0);
    if (per_cu < 1) per_cu = 1;
    if (per_cu > 1) per_cu = 1;
    grid_blocks = (cus * per_cu) & ~7;
  }
  int coop = 1;
  void* args[] = {&p, &coop};
  if (hipMemsetAsync(p.bar, 0, (size_t)XCD_BAR_WORDS * 4, stream) != hipSuccess) fprintf(stderr, "memset failed\n");
  hipError_t e = hipLaunchCooperativeKernel((void*)mega, dim3(grid_blocks), dim3(512), args, 0, stream);
  if (e != hipSuccess) fprintf(stderr, "cooperative launch failed: %s (grid %d)\n", hipGetErrorString(e), grid_blocks);
}
```

```cpp
#include <hip/hip_runtime.h>
#include <hip/hip_bf16.h>
#include <hip/hip_cooperative_groups.h>
#include <cstdio>
#ifndef PROBE
#define PROBE 0
#endif
namespace cg = cooperative_groups;

typedef unsigned short u16;
using bf16x8 = __attribute__((ext_vector_type(8))) short;
using f32x4 = __attribute__((ext_vector_type(4))) float;
using u32x4 = __attribute__((ext_vector_type(4))) unsigned;
#define DEV __device__ __forceinline__

constexpr int D = 1024, NB = 32, SEQ = 2048, NCTX = 256, NTOK = 2304, DEPTH = 4;
constexpr int NIN = 8608, NINP = 8704;
constexpr int G = 8, NGRP = NB / G, TG = G * NTOK;
constexpr int NSEG = 36;
constexpr int C_CQ = 0, C_CKV = 256, C_KR = 384, C_GMLA = 416, C_HQ = 928, C_HI = 1440, C_HF = 1952,
              C_GHG = 2976, C_CX = 3488, C_CB = 4000, C_CC = 4512, C_GCV = 5024, C_BRG = 5536;
constexpr float QSCALE = 0.10206207261596575f * 1.4426950408889634f;

struct Params {
  const float *x, *c, *ctx, *c_ctx, *ada_w, *ada_b, *norm_g, *w_in, *q_norm_g, *kv_norm_g, *w_uq, *w_ukv,
      *lb_logits, *hg_norm_g, *conv_w, *conv_b, *w_branch, *w_out, *final_g;
  float* out;
  u16 *WinT, *WuqT, *WukvT, *WbrT, *WoutT;
  float *mod, *lb, *rope, *hctx;
  u16 *u, *z, *Q, *Kc, *Vt, *Y, *mg;
  float *ob, *Dseg;
  u16* Sloc;
  unsigned* bar;
};

DEV float bf2f(u16 h) { return __uint_as_float(((unsigned)h) << 16); }
DEV u16 f2bf(float f) {
  unsigned u = __float_as_uint(f);
  u += 0x7fffu + ((u >> 16) & 1u);
  return (u16)(u >> 16);
}
typedef __bf16 bf16x2_t __attribute__((ext_vector_type(2)));
typedef float f32x2_t __attribute__((ext_vector_type(2)));
DEV unsigned pack2(float a, float b) {
  f32x2_t v = {a, b};
  return __builtin_bit_cast(unsigned, __builtin_convertvector(v, bf16x2_t));
}
DEV float bflo(unsigned w) { return __uint_as_float(w << 16); }
DEV float bfhi(unsigned w) { return __uint_as_float(w & 0xffff0000u); }
DEV float rcpf(float x) { return __builtin_amdgcn_rcpf(x); }
DEV float ex2(float x) { return __builtin_amdgcn_exp2f(x); }
DEV float sigm(float x) { return rcpf(1.f + ex2(x * -1.4426950408889634f)); }
DEV float siluf(float x) { return x * sigm(x); }
DEV float shx(float v, int mask, int lane) {
  return __builtin_bit_cast(float, __builtin_amdgcn_ds_bpermute((lane ^ mask) << 2, __builtin_bit_cast(int, v)));
}
DEV float wsum(float v, int lane) {
#pragma unroll
  for (int m = 32; m >= 1; m >>= 1) v += shx(v, m, lane);
  return v;
}

template <int ROWS>
DEV void stage_tile(const u16* __restrict__ gbase, long ld, int k0, char* lds, int tid) {
#pragma unroll
  for (int i = 0; i < ROWS / 64; ++i) {
    int idx = i * 512 + tid;
    int r = idx >> 3, s = idx & 7;
    int c = s ^ ((r >> 1) & 7);
    const u16* g = gbase + (long)r * ld + k0 + c * 8;
    __builtin_amdgcn_global_load_lds((const unsigned*)g, (unsigned*)(lds + idx * 16), 16, 0, 0);
  }
}
DEV bf16x8 lds_frag(const char* tile, int row, int chunk) {
  return *(const bf16x8*)(tile + row * 128 + ((chunk ^ ((row >> 1) & 7)) << 4));
}

template <int WN, int WT>
DEV void gemm_mainloop(const u16* __restrict__ Wt, long ldw, const u16* __restrict__ A, long lda, int K,
                       char* smem, int tid, f32x4 (&acc)[WN][WT]) {
  constexpr int NR = WN * 64, TR = WT * 32;
  constexpr int WB = NR * 128, STG = (NR + TR) * 128;
  constexpr int NLD = (NR + TR) / 64;
  static_assert(3 * STG <= 147456, "LDS stages");
  const int wid = tid >> 6, lane = tid & 63, fr = lane & 15, fq = lane >> 4, wn = wid & 3, wt = wid >> 2;
  const int nk = K >> 6;
  __syncthreads();
  stage_tile<NR>(Wt, ldw, 0, smem, tid);
  stage_tile<TR>(A, lda, 0, smem + WB, tid);
  if (nk > 1) {
    stage_tile<NR>(Wt, ldw, 64, smem + STG, tid);
    stage_tile<TR>(A, lda, 64, smem + STG + WB, tid);
  }
  int cur = 0;
#pragma nounroll
  for (int kt = 0; kt < nk; ++kt) {
    if (kt + 1 < nk) asm volatile("s_waitcnt vmcnt(%0)" ::"n"(NLD) : "memory");
    else asm volatile("s_waitcnt vmcnt(0)" ::: "memory");
    __builtin_amdgcn_s_barrier();
    asm volatile("" ::: "memory");
    if (kt + 2 < nk) {
      int nx = cur + 2;
      if (nx >= 3) nx -= 3;
      char* nbuf = smem + nx * STG;
      stage_tile<NR>(Wt, ldw, (kt + 2) * 64, nbuf, tid);
      stage_tile<TR>(A, lda, (kt + 2) * 64, nbuf + WB, tid);
    }
    const char* wb = smem + cur * STG;
    const char* ab = wb + WB;
#pragma unroll
    for (int ks = 0; ks < 2; ++ks) {
      bf16x8 wf[WN], af[WT];
#pragma unroll
      for (int n = 0; n < WN; ++n) wf[n] = lds_frag(wb, wn * (WN * 16) + n * 16 + fr, ks * 4 + fq);
#pragma unroll
      for (int t = 0; t < WT; ++t) af[t] = lds_frag(ab, wt * (WT * 16) + t * 16 + fr, ks * 4 + fq);
#pragma unroll
      for (int n = 0; n < WN; ++n)
#pragma unroll
        for (int t = 0; t < WT; ++t)
          acc[n][t] = __builtin_amdgcn_mfma_f32_16x16x32_bf16(wf[n], af[t], acc[n][t], 0, 0, 0);
    }
    cur = (cur == 2) ? 0 : cur + 1;
  }
}

template <int WN, int WT>
DEV void zero_acc(f32x4 (&acc)[WN][WT]) {
#pragma unroll
  for (int n = 0; n < WN; ++n)
#pragma unroll
    for (int t = 0; t < WT; ++t) acc[n][t] = f32x4{0.f, 0.f, 0.f, 0.f};
}


DEV int g8_lds_byte(int r, int c) {
  int st = (r >> 4) * 2 + (c >> 5), rr = r & 15, cc = c & 31, ob = rr * 64 + cc * 2;
  return st * 1024 + (ob ^ (((ob >> 9) & 1) << 5));
}
DEV void g8_stage_rc(int b, int& R, int& C) {
  int st = b / 1024, sb = b % 1024, swz = sb ^ (((sb >> 9) & 1) << 5);
  R = (st >> 1) * 16 + swz / 64;
  C = (st & 1) * 32 + (swz % 64) / 2;
}
template <int K, bool PRE>
DEV void gemm8_tile(const u16* __restrict__ A, const u16* __restrict__ Bt, char* smem, const int tid,
                    f32x4 (&acc)[2][2][4][2]) {
  constexpr int BK = 64, HALF = 128, HT = HALF * BK;
  u16* shm = (u16*)smem;
#define SA(b, h) (shm + ((b)*2 + (h)) * HT)
#define SB(b, h) (shm + (4 + (b)*2 + (h)) * HT)
#define STAGE(P, BASE, br, kt)                                                                         \
  do {                                                                                                 \
    long _g = (long)(br)*K + (long)(kt)*BK;                                                            \
    for (int _i = 0; _i < 2; ++_i) {                                                                   \
      int _b = tid * 16 + _i * 8192;                                                                   \
      int _r, _c;                                                                                      \
      g8_stage_rc(_b, _r, _c);                                                                         \
      __builtin_amdgcn_global_load_lds((const unsigned*)(BASE + _g + (long)_r * K + _c),               \
                                       (unsigned*)((char*)(P) + _b), 16, 0, 0);                        \
    }                                                                                                  \
  } while (0)
#define LDA(dst, b, h)                                                                                 \
  for (int m = 0; m < 4; ++m)                                                                          \
    for (int k = 0; k < 2; ++k)                                                                        \
      dst[m][k] = *reinterpret_cast<const bf16x8*>((char*)SA(b, h) + g8_lds_byte(wr * 64 + m * 16 + fr, k * 32 + fq * 8))
#define LDB(dst, b, h)                                                                                 \
  for (int n = 0; n < 2; ++n)                                                                          \
    for (int k = 0; k < 2; ++k)                                                                        \
      dst[n][k] = *reinterpret_cast<const bf16x8*>((char*)SB(b, h) + g8_lds_byte(wc * 32 + n * 16 + fr, k * 32 + fq * 8))
#define MMA(ai, bj, At_, Bt_)                                                                          \
  do {                                                                                                 \
    __builtin_amdgcn_s_setprio(1);                                                                     \
    for (int m = 0; m < 4; ++m)                                                                        \
      for (int n = 0; n < 2; ++n)                                                                      \
        for (int k = 0; k < 2; ++k)                                                                    \
          acc[ai][bj][m][n] = __builtin_amdgcn_mfma_f32_16x16x32_bf16(At_[m][k], Bt_[n][k], acc[ai][bj][m][n], 0, 0, 0); \
    __builtin_amdgcn_s_setprio(0);                                                                     \
  } while (0)
#define WAIT_V(n) asm volatile("s_waitcnt vmcnt(" #n ")" ::: "memory")
#define WAIT_L(n) asm volatile("s_waitcnt lgkmcnt(" #n ")" ::: "memory")
#define BAR __builtin_amdgcn_s_barrier()
#define SCHED __builtin_amdgcn_sched_barrier(0)
  const int wid = tid >> 6, lane = tid & 63, wr = wid >> 2, wc = wid & 3, fr = lane & 15, fq = lane >> 4;
  const int brow = 0, bcol = 0;
  bf16x8 At[4][2], B0[2][2], B1[2][2];
  const int nt = K / BK;
  if (!PRE) {
    STAGE(SB(0, 0), Bt, bcol, 0); STAGE(SA(0, 0), A, brow, 0);
    STAGE(SB(0, 1), Bt, bcol + HALF, 0); STAGE(SA(0, 1), A, brow + HALF, 0);
  }
  if (wr == 1) BAR;
  if (PRE) WAIT_V(0); else WAIT_V(4);
  BAR;
  STAGE(SB(1, 0), Bt, bcol, 1); STAGE(SA(1, 0), A, brow, 1); STAGE(SB(1, 1), Bt, bcol + HALF, 1);
  WAIT_V(6); BAR;
#pragma nounroll
  for (int t = 0; t < nt - 2; t += 2) {
    LDB(B0, 0, 0); SCHED; LDA(At, 0, 0); STAGE(SA(1, 1), A, brow + HALF, t + 1);
    WAIT_L(8); BAR; WAIT_L(0); MMA(0, 0, At, B0); BAR; SCHED;
    LDB(B1, 0, 1); STAGE(SB(0, 0), Bt, bcol, t + 2);
    BAR; WAIT_L(0); MMA(0, 1, At, B1); BAR;
    LDA(At, 0, 1); STAGE(SA(0, 0), A, brow, t + 2);
    BAR; WAIT_L(0); MMA(1, 0, At, B0); BAR; SCHED;
    STAGE(SB(0, 1), Bt, bcol + HALF, t + 2);
    WAIT_V(6); BAR; MMA(1, 1, At, B1); BAR;
    LDB(B0, 1, 0); SCHED; LDA(At, 1, 0); STAGE(SA(0, 1), A, brow + HALF, t + 2);
    WAIT_L(8); BAR; WAIT_L(0); MMA(0, 0, At, B0); BAR; SCHED;
    LDB(B1, 1, 1); STAGE(SB(1, 0), Bt, bcol, t + 3);
    BAR; WAIT_L(0); MMA(0, 1, At, B1); BAR;
    LDA(At, 1, 1); STAGE(SA(1, 0), A, brow, t + 3);
    BAR; WAIT_L(0); MMA(1, 0, At, B0); BAR; SCHED;
    STAGE(SB(1, 1), Bt, bcol + HALF, t + 3);
    WAIT_V(6); BAR; MMA(1, 1, At, B1); BAR;
  }
  { LDB(B0, 0, 0); LDA(At, 0, 0); STAGE(SA(1, 1), A, brow + HALF, nt - 1);
    BAR; WAIT_L(0); MMA(0, 0, At, B0); BAR;
    LDB(B1, 0, 1); BAR; WAIT_L(0); MMA(0, 1, At, B1); BAR;
    LDA(At, 0, 1); WAIT_V(4); BAR; WAIT_L(0); MMA(1, 0, At, B0); MMA(1, 1, At, B1); BAR; }
  { LDB(B0, 1, 0); LDA(At, 1, 0); WAIT_V(2); BAR; WAIT_L(0); MMA(0, 0, At, B0); BAR;
    LDB(B1, 1, 1); WAIT_V(0); BAR; WAIT_L(0); MMA(0, 1, At, B1); BAR;
    LDA(At, 1, 1); BAR; WAIT_L(0); MMA(1, 0, At, B0); MMA(1, 1, At, B1); BAR; }
  if (wr == 0) BAR;
#undef SA
#undef SB
#undef STAGE
#undef LDA
#undef LDB
#undef MMA
#undef WAIT_V
#undef WAIT_L
#undef BAR
#undef SCHED
}


template <int K>
DEV void gemm8_prefetch(const u16* __restrict__ A, const u16* __restrict__ Bt, char* smem, const int tid) {
  constexpr int HT = 128 * 64;
  u16* shm = (u16*)smem;
  const u16* bases[4] = {Bt, A, Bt + (long)128 * K, A + (long)128 * K};
  const int slots[4] = {4, 0, 5, 1};
#pragma unroll
  for (int q = 0; q < 4; ++q)
#pragma unroll
    for (int i = 0; i < 2; ++i) {
      int b = tid * 16 + i * 8192, r, c;
      g8_stage_rc(b, r, c);
      __builtin_amdgcn_global_load_lds((const unsigned*)(bases[q] + (long)r * K + c), (unsigned*)((char*)(shm + slots[q] * HT) + b), 16, 0, 0);
    }
}

DEV void transpose_item(const float* __restrict__ src, int N, int K, u16* __restrict__ dst,
                        const float* __restrict__ gain, int tn, int tk, char* smem, int tid) {
  float* tile = (float*)smem;
  __syncthreads();
#pragma unroll
  for (int i = 0; i < 2; ++i) {
    int kk = (tid >> 4) + 32 * i, n4 = (tid & 15) * 4;
    int k = tk * 64 + kk, n = tn * 64 + n4;
    float4 v = make_float4(0.f, 0.f, 0.f, 0.f);
    if (n < N) v = *(const float4*)(src + (long)k * N + n);
    float gsc = gain ? gain[k] : 1.f;
    tile[kk * 65 + n4 + 0] = v.x * gsc;
    tile[kk * 65 + n4 + 1] = v.y * gsc;
    tile[kk * 65 + n4 + 2] = v.z * gsc;
    tile[kk * 65 + n4 + 3] = v.w * gsc;
  }
  __syncthreads();
  int n = tid >> 3, kc = (tid & 7) * 8;
  uint4 o;
  o.x = pack2(tile[(kc + 0) * 65 + n], tile[(kc + 1) * 65 + n]);
  o.y = pack2(tile[(kc + 2) * 65 + n], tile[(kc + 3) * 65 + n]);
  o.z = pack2(tile[(kc + 4) * 65 + n], tile[(kc + 5) * 65 + n]);
  o.w = pack2(tile[(kc + 6) * 65 + n], tile[(kc + 7) * 65 + n]);
  *(uint4*)(dst + (long)(tn * 64 + n) * K + tk * 64 + kc) = o;
}

constexpr int PRE_T_IN = DEPTH * 136 * 16;
constexpr int PRE_T_UQ = DEPTH * 12 * 4;
constexpr int PRE_T_UKV = DEPTH * 16 * 2;
constexpr int PRE_T_BR = DEPTH * 3 * 16 * 8;
constexpr int PRE_T_OUT = DEPTH * 16 * 16;
constexpr int PRE_MOD = DEPTH * 48;
constexpr int PRE_ITEMS = PRE_MOD + 1 + PRE_T_IN + PRE_T_UQ + PRE_T_UKV + PRE_T_BR + PRE_T_OUT;

DEV void mod_item(const Params& p, int it, char* smem, int tid) {
  const int l = it / 48, c0 = (it % 48) * 64;
  float* sl = (float*)smem;
  const int c = tid & 63, ks = tid >> 6;
  float acc[33];
#pragma unroll
  for (int r = 0; r < 33; ++r) acc[r] = 0.f;
  for (int half = 0; half < 2; ++half) {
    __syncthreads();
    for (int e = tid; e < 33 * 512; e += 512) {
      int r = e >> 9, kk = e & 511;
      float v = (r < 32) ? p.c[r * 1024 + half * 512 + kk] : p.c_ctx[half * 512 + kk];
      sl[e] = v / (1.f + expf(-v));
    }
    __syncthreads();
    const float* wp = p.ada_w + ((long)l * 1024 + half * 512 + ks * 64) * 3072 + c0 + c;
    for (int kk = 0; kk < 64; ++kk) {
      float w = wp[(long)kk * 3072];
      const float* sp = sl + ks * 64 + kk;
#pragma unroll
      for (int r = 0; r < 33; ++r) acc[r] = fmaf(sp[r * 512], w, acc[r]);
    }
  }
  __syncthreads();
  float* red = (float*)smem;
#pragma unroll
  for (int r = 0; r < 33; ++r) red[(ks * 33 + r) * 64 + c] = acc[r];
  __syncthreads();
  for (int e = tid; e < 33 * 64; e += 512) {
    int r = e >> 6, cc = e & 63;
    float s = 0.f;
#pragma unroll
    for (int k = 0; k < 8; ++k) s += red[(k * 33 + r) * 64 + cc];
    p.mod[((long)l * 33 + r) * 3072 + c0 + cc] = s + p.ada_b[l * 3072 + c0 + cc];
  }
}

DEV void misc_item(const Params& p, int tid) {
  for (int e = tid; e < 1024; e += 512) {
    float lg[4], mx = -1e30f;
#pragma unroll
    for (int l = 0; l < 4; ++l) { lg[l] = p.lb_logits[l * 1024 + e]; mx = fmaxf(mx, lg[l]); }
    float sum = 0.f;
#pragma unroll
    for (int l = 0; l < 4; ++l) { lg[l] = expf(lg[l] - mx); sum += lg[l]; }
    float cum0 = lg[0] / sum, cum = cum0;
    p.lb[e] = 0.f;
#pragma unroll
    for (int l = 1; l < 4; ++l) { cum += lg[l] / sum; p.lb[l * 1024 + e] = cum - cum0; }
  }
  for (int e = tid; e < 512; e += 512) {
    int pos = e >> 3, pr = e & 7;
    float inv = powf(10000.f, -(float)pr / 8.f);
    float ang = (float)pos * inv;
    p.rope[e * 2] = cosf(ang);
    p.rope[e * 2 + 1] = sinf(ang);
  }
}

DEV void pre_item(const Params& p, int it, char* smem, int tid) {
  if (it < PRE_MOD) { mod_item(p, it, smem, tid); return; }
  it -= PRE_MOD;
  if (it < 1) { misc_item(p, tid); return; }
  it -= 1;
  if (it < PRE_T_IN) {
    int l = it / 2176, r = it % 2176;
    transpose_item(p.w_in + (long)l * 1024 * NIN, NIN, 1024, p.WinT + (long)l * NINP * 1024, nullptr, r / 16, r % 16, smem, tid);
    return;
  }
  it -= PRE_T_IN;
  if (it < PRE_T_UQ) {
    int l = it / 48, r = it % 48;
    transpose_item(p.w_uq + (long)l * 256 * 768, 768, 256, p.WuqT + (long)l * 768 * 256, p.q_norm_g + l * 256, r / 4, r % 4, smem, tid);
    return;
  }
  it -= PRE_T_UQ;
  if (it < PRE_T_UKV) {
    int l = it / 32, r = it % 32;
    transpose_item(p.w_ukv + (long)l * 128 * 1024, 1024, 128, p.WukvT + (long)l * 1024 * 128, p.kv_norm_g + l * 128, r / 2, r % 2, smem, tid);
    return;
  }
  it -= PRE_T_UKV;
  if (it < PRE_T_BR) {
    int m = it / 128, r = it % 128;
    transpose_item(p.w_branch + (long)m * 512 * 1024, 1024, 512, p.WbrT + (long)m * 1024 * 512, nullptr, r / 8, r % 8, smem, tid);
    return;
  }
  it -= PRE_T_BR;
  {
    int l = it / 256, r = it % 256;
    transpose_item(p.w_out + (long)l * 1024 * 1024, 1024, 1024, p.WoutT + (long)l * 1024 * 1024, nullptr, r / 16, r % 16, smem, tid);
  }
}

DEV void norm_item(const Params& p, int l, int g, int item, int tid) {
  const int wid = tid >> 6, lane = tid & 63;
  const int r = item * 8 + wid;
  const int bl = r / NTOK, j = r % NTOK, b = g * G + bl;
  const float* src;
  int mrow;
  if (j < NCTX) {
    src = (l == 0 ? p.ctx : p.hctx) + ((long)b * NCTX + j) * D;
    mrow = 32;
  } else {
    src = (l == 0 ? p.x : p.out) + ((long)b * SEQ + (j - NCTX)) * D;
    mrow = b;
  }
  const float* md = p.mod + ((long)l * 33 + mrow) * 3072;
  const float* ng = p.norm_g + l * D;
  float4 v[4];
  float ss = 0.f;
#pragma unroll
  for (int i = 0; i < 4; ++i) {
    v[i] = *(const float4*)(src + i * 256 + lane * 4);
    ss += v[i].x * v[i].x + v[i].y * v[i].y + v[i].z * v[i].z + v[i].w * v[i].w;
  }
  ss = wsum(ss, lane);
  const float rstd = rsqrtf(ss * (1.f / D) + 1e-6f);
#pragma unroll
  for (int i = 0; i < 4; ++i) {
    int col = i * 256 + lane * 4;
    float4 gg = *(const float4*)(ng + col);
    float4 sh = *(const float4*)(md + col);
    float4 sc = *(const float4*)(md + 1024 + col);
    uint2 o;
    o.x = pack2(v[i].x * rstd * gg.x * (1.f + sc.x) + sh.x, v[i].y * rstd * gg.y * (1.f + sc.y) + sh.y);
    o.y = pack2(v[i].z * rstd * gg.z * (1.f + sc.z) + sh.z, v[i].w * rstd * gg.w * (1.f + sc.w) + sh.w);
    *(uint2*)(p.u + (long)r * D + col) = o;
  }
}

DEV void final_norm_item(const Params& p, int g, int item, int tid) {
  const int wid = tid >> 6, lane = tid & 63;
  const int r = item * 8 + wid;
  float* row = p.out + ((long)g * G * SEQ + r) * D;
  float4 v[4];
  float ss = 0.f;
#pragma unroll
  for (int i = 0; i < 4; ++i) {
    v[i] = *(const float4*)(row + i * 256 + lane * 4);
    ss += v[i].x * v[i].x + v[i].y * v[i].y + v[i].z * v[i].z + v[i].w * v[i].w;
  }
  ss = wsum(ss, lane);
  const float rstd = rsqrtf(ss * (1.f / D) + 1e-6f);
#pragma unroll
  for (int i = 0; i < 4; ++i) {
    int col = i * 256 + lane * 4;
    float4 gg = *(const float4*)(p.final_g + col);
    float4 o = make_float4(v[i].x * rstd * gg.x, v[i].y * rstd * gg.y, v[i].z * rstd * gg.z, v[i].w * rstd * gg.w);
    *(float4*)(row + col) = o;
  }
}

DEV int colkind(int f) {
  if (f < C_GMLA) return 0;
  if (f < C_HQ) return 1;
  if (f < C_HF) return 0;
  if (f < C_HF + 512) return 3;
  if (f < C_GHG) return 4;
  if (f < C_CX) return 1;
  if (f < C_GCV) return 0;
  if (f < C_BRG) return 1;
  if (f < NIN) return 2;
  return 5;
}

DEV void inproj_item(const Params& p, int l, int tt, int tf, int ntt, int ntf, char* smem, int tid) {
  const int t0 = tt * 256, f0 = tf * 256;
  f32x4 acc[2][2][4][2];
#pragma unroll
  for (int a = 0; a < 2; ++a)
#pragma unroll
    for (int b = 0; b < 2; ++b)
#pragma unroll
      for (int m = 0; m < 4; ++m)
#pragma unroll
        for (int n = 0; n < 2; ++n) acc[a][b][m][n] = f32x4{0.f, 0.f, 0.f, 0.f};
  gemm8_tile<1024, true>(p.WinT + ((long)l * NINP + f0) * 1024, p.u + (long)t0 * 1024, smem, tid, acc);
  if (ntt >= 0) gemm8_prefetch<1024>(p.WinT + ((long)l * NINP + ntf * 256) * 1024, p.u + (long)ntt * 256 * 1024, smem, tid);
  const int wid = tid >> 6, lane = tid & 63, fr = lane & 15, fq = lane >> 4, wr = wid >> 2, wc = wid & 3;
#pragma unroll
  for (int ai = 0; ai < 2; ++ai)
#pragma unroll
    for (int m = 0; m < 4; ++m) {
      const int fb = f0 + ai * 128 + wr * 64 + m * 16;
      const int kind = colkind(fb);
      if (kind == 5) continue;
      const int f = fb + fq * 4;
      float4 lbv = make_float4(0.f, 0.f, 0.f, 0.f);
      if (kind == 3) lbv = *(const float4*)(p.lb + l * 1024 + (f - C_HF));
      if (kind == 4) lbv = *(const float4*)(p.lb + l * 1024 + 512 + (f - C_HF - 512));
#pragma unroll
      for (int bj = 0; bj < 2; ++bj)
#pragma unroll
        for (int n = 0; n < 2; ++n) {
          const int r = t0 + bj * 128 + wc * 32 + n * 16 + fr;
          const f32x4 a = acc[ai][bj][m][n];
          float o0, o1, o2, o3;
          if (kind == 0) { o0 = a[0]; o1 = a[1]; o2 = a[2]; o3 = a[3]; }
          else if (kind == 1) { o0 = siluf(a[0]); o1 = siluf(a[1]); o2 = siluf(a[2]); o3 = siluf(a[3]); }
          else if (kind == 2) { o0 = sigm(a[0]); o1 = sigm(a[1]); o2 = sigm(a[2]); o3 = sigm(a[3]); }
          else {
            o0 = (1.f - lbv.x) * sigm(-a[0]); o1 = (1.f - lbv.y) * sigm(-a[1]);
            o2 = (1.f - lbv.z) * sigm(-a[2]); o3 = (1.f - lbv.w) * sigm(-a[3]);
          }
          uint2 o;
          o.x = pack2(o0, o1);
          o.y = pack2(o2, o3);
          *(uint2*)(p.z + (long)r * NINP + f) = o;
        }
    }
}

DEV void row_scales(const u16* __restrict__ zrow0, int col0, int ncol, float* rs, int tid) {
  if (tid >= 384) return;
  const int r = tid >> 1, h = tid & 1, lane = tid & 63;
  const u16* s = zrow0 + (long)r * NINP + col0 + h * (ncol / 2);
  float ss = 0.f;
  for (int i = 0; i < ncol / 2; i += 8) {
    uint4 v = *(const uint4*)(s + i);
    ss += bflo(v.x) * bflo(v.x) + bfhi(v.x) * bfhi(v.x) + bflo(v.y) * bflo(v.y) + bfhi(v.y) * bfhi(v.y) +
          bflo(v.z) * bflo(v.z) + bfhi(v.z) * bfhi(v.z) + bflo(v.w) * bflo(v.w) + bfhi(v.w) * bfhi(v.w);
  }
  ss += shx(ss, 1, lane);
  if (h == 0) rs[r] = rsqrtf(ss / (float)ncol + 1e-6f);
}

DEV void qproj_item(const Params& p, int l, int tt, int tf, char* smem, int tid) {
  const int t0 = tt * 192, f0 = tf * 128;
  f32x4 acc[2][6];
  zero_acc<2, 6>(acc);
  float* rs = (float*)(smem + 122880);
  __syncthreads();
  row_scales(p.z + (long)t0 * NINP, C_CQ, 256, rs, tid);
  gemm_mainloop<2, 6>(p.WuqT + ((long)l * 768 + f0) * 256, 256, p.z + (long)t0 * NINP + C_CQ, NINP, 256, smem, tid, acc);
  const int wid = tid >> 6, lane = tid & 63, fr = lane & 15, fq = lane >> 4, wn = wid & 3, wt = wid >> 2;
  const int bl = t0 / NTOK, j0 = t0 % NTOK;
#pragma unroll
  for (int n = 0; n < 2; ++n) {
    const int fb = f0 + wn * 32 + n * 16;
    const int head = fb / 96, part = (fb % 96) >> 4;
    const int dd = part * 16 + fq * 4;
#pragma unroll
    for (int t = 0; t < 6; ++t) {
      const int tl = wt * 96 + t * 16 + fr;
      const int j = j0 + tl;
      const float sc = rs[tl];
      float v0 = acc[n][t][0] * sc, v1 = acc[n][t][1] * sc, v2 = acc[n][t][2] * sc, v3 = acc[n][t][3] * sc;
      if (part >= 4) {
        float p0 = shx(v0, 32, lane), p1 = shx(v1, 32, lane), p2 = shx(v2, 32, lane), p3 = shx(v3, 32, lane);
        if (j >= NCTX) {
          const int tq = j - NCTX;
          const int pos = (part == 4) ? (tq >> 6) : (tq & 63);
          const float* rp = p.rope + (pos * 8 + (fq & 1) * 4) * 2;
          float4 cs01 = *(const float4*)rp, cs23 = *(const float4*)(rp + 4);
          if ((fq >> 1) == 0) {
            v0 = v0 * cs01.x - p0 * cs01.y; v1 = v1 * cs01.z - p1 * cs01.w;
            v2 = v2 * cs23.x - p2 * cs23.y; v3 = v3 * cs23.z - p3 * cs23.w;
          } else {
            v0 = p0 * cs01.y + v0 * cs01.x; v1 = p1 * cs01.w + v1 * cs01.z;
            v2 = p2 * cs23.y + v2 * cs23.x; v3 = p3 * cs23.w + v3 * cs23.z;
          }
        }
      }
      uint2 o;
      o.x = pack2(v0 * QSCALE, v1 * QSCALE);
      o.y = pack2(v2 * QSCALE, v3 * QSCALE);
      *(uint2*)(p.Q + ((long)(bl * 8 + head) * NTOK + j) * 96 + dd) = o;
      asm volatile("" ::: "memory");
    }
  }
}

DEV void kvproj_item(const Params& p, int l, int tt, int tf, char* smem, int tid) {
  const int t0 = tt * 192, f0 = tf * 128;
  f32x4 acc[2][6];
  zero_acc<2, 6>(acc);
  float* rs = (float*)(smem + 122880);
  __syncthreads();
  row_scales(p.z + (long)t0 * NINP, C_CKV, 128, rs, tid);
  gemm_mainloop<2, 6>(p.WukvT + ((long)l * 1024 + f0) * 128, 128, p.z + (long)t0 * NINP + C_CKV, NINP, 128, smem, tid, acc);
  const int wid = tid >> 6, lane = tid & 63, fr = lane & 15, fq = lane >> 4, wn = wid & 3, wt = wid >> 2;
  const int bl = t0 / NTOK, j0 = t0 % NTOK;
#pragma unroll
  for (int n = 0; n < 2; ++n) {
    const int fb = f0 + wn * 32 + n * 16;
    const int head = fb >> 7, dd = (fb & 127) + fq * 4;
#pragma unroll
    for (int t = 0; t < 6; ++t) {
      const int tl = wt * 96 + t * 16 + fr;
      const int j = j0 + tl;
      const float sc = rs[tl];
      float v0 = acc[n][t][0] * sc, v1 = acc[n][t][1] * sc, v2 = acc[n][t][2] * sc, v3 = acc[n][t][3] * sc;
      if (dd < 64) {
        uint2 o;
        o.x = pack2(v0, v1);
        o.y = pack2(v2, v3);
        *(uint2*)(p.Kc + ((long)(bl * 8 + head) * NTOK + j) * 96 + dd) = o;
      } else {
        u16* vp = p.Vt + ((long)(bl * 8 + head) * 64 + (dd - 64)) * NTOK + j;
        vp[0] = f2bf(v0);
        vp[NTOK] = f2bf(v1);
        vp[2 * NTOK] = f2bf(v2);
        vp[3 * NTOK] = f2bf(v3);
      }
    }
  }
}

DEV void krope_item(const Params& p, int item, int tid) {
  const int r = item * 256 + (tid >> 1), axis = tid & 1;
  const int bl = r / NTOK, j = r % NTOK;
  const u16* s = p.z + (long)r * NINP + C_KR + axis * 16;
  uint4 a = *(const uint4*)s, b = *(const uint4*)(s + 8);
  float x1[8] = {bflo(a.x), bfhi(a.x), bflo(a.y), bfhi(a.y), bflo(a.z), bfhi(a.z), bflo(a.w), bfhi(a.w)};
  float x2[8] = {bflo(b.x), bfhi(b.x), bflo(b.y), bfhi(b.y), bflo(b.z), bfhi(b.z), bflo(b.w), bfhi(b.w)};
  if (j >= NCTX) {
    const int tq = j - NCTX;
    const int pos = axis == 0 ? (tq >> 6) : (tq & 63);
    const float* rp = p.rope + pos * 16;
#pragma unroll
    for (int i = 0; i < 8; ++i) {
      float c = rp[i * 2], sn = rp[i * 2 + 1];
      float y1 = x1[i] * c - x2[i] * sn, y2 = x1[i] * sn + x2[i] * c;
      x1[i] = y1;
      x2[i] = y2;
    }
  }
  uint4 oa, ob;
  oa.x = pack2(x1[0], x1[1]); oa.y = pack2(x1[2], x1[3]); oa.z = pack2(x1[4], x1[5]); oa.w = pack2(x1[6], x1[7]);
  ob.x = pack2(x2[0], x2[1]); ob.y = pack2(x2[2], x2[3]); ob.z = pack2(x2[4], x2[5]); ob.w = pack2(x2[6], x2[7]);
#pragma unroll
  for (int h = 0; h < 8; ++h) {
    u16* d = p.Kc + ((long)(bl * 8 + h) * NTOK + j) * 96 + 64 + axis * 16;
    *(uint4*)d = oa;
    *(uint4*)(d + 8) = ob;
  }
}

DEV void hg_combine_item(const Params& p, int item, int tid) {
  const int e = (item * 512 + tid) * 2;
  const int sc = e >> 12, el = e & 4095, d = el & 63;
  u16* base = p.Sloc + (long)sc * NSEG * 4096 + el;
  const float* db = p.Dseg + (long)sc * NSEG * 64 + d;
  unsigned vals[NSEG - 1];
  float2 dd[NSEG - 1];
#pragma unroll
  for (int k = 0; k < NSEG - 1; ++k) { vals[k] = *(const unsigned*)(base + (long)k * 4096); dd[k] = *(const float2*)(db + k * 64); }
  float s0 = bflo(vals[0]), s1 = bfhi(vals[0]);
#pragma unroll
  for (int k = 1; k < NSEG - 1; ++k) {
    s0 = fmaf(dd[k].x, s0, bflo(vals[k]));
    s1 = fmaf(dd[k].y, s1, bfhi(vals[k]));
    *(unsigned*)(base + (long)k * 4096) = pack2(s0, s1);
  }
}

constexpr int KROW = 208, VROW = 272, KBYTES = 128 * KROW, ASTG = KBYTES + 64 * VROW;

DEV void attn_item(const Params& p, int bl, int head, int q0, int nkeys, char* smem, int tid) {
  const int wid = tid >> 6, lane = tid & 63, fr = lane & 15, fq = lane >> 4;
  const long bh = bl * 8 + head;
  const u16* Qp = p.Q + (bh * NTOK + q0 + wid * 32) * 96;
  const u16* Kg = p.Kc + bh * NTOK * 96;
  const u16* Vg = p.Vt + bh * 64 * NTOK;
  bf16x8 qf[2][3];
#pragma unroll
  for (int qt = 0; qt < 2; ++qt)
#pragma unroll
    for (int ks = 0; ks < 3; ++ks) qf[qt][ks] = *(const bf16x8*)(Qp + (qt * 16 + fr) * 96 + ks * 32 + fq * 8);
  f32x4 o[4][2];
#pragma unroll
  for (int a = 0; a < 4; ++a)
#pragma unroll
    for (int b = 0; b < 2; ++b) o[a][b] = f32x4{0.f, 0.f, 0.f, 0.f};
  const int nt = nkeys >> 7;
  u32x4 kr[3], vr[2];
  int koff[3], voffg[2], voffl[2];
#pragma unroll
  for (int i = 0; i < 3; ++i) { int c = i * 512 + tid; koff[i] = (c / 12) * KROW + (c % 12) * 16; }
#pragma unroll
  for (int i = 0; i < 2; ++i) { int c = i * 512 + tid; voffg[i] = (c >> 4) * NTOK + (c & 15) * 8; voffl[i] = (c >> 4) * VROW + (c & 15) * 16; }
  __syncthreads();
#pragma unroll
  for (int i = 0; i < 3; ++i) kr[i] = *(const u32x4*)(Kg + (long)(i * 512 + tid) * 8);
#pragma unroll
  for (int i = 0; i < 2; ++i) vr[i] = *(const u32x4*)(Vg + voffg[i]);
#pragma unroll
  for (int i = 0; i < 3; ++i) *(u32x4*)(smem + koff[i]) = kr[i];
#pragma unroll
  for (int i = 0; i < 2; ++i) *(u32x4*)(smem + KBYTES + voffl[i]) = vr[i];
  __syncthreads();
  f32x4 negm[2];
  {
    f32x4 s0[8][2];
#pragma unroll
    for (int kf = 0; kf < 8; ++kf) {
      s0[kf][0] = f32x4{0.f, 0.f, 0.f, 0.f};
      s0[kf][1] = f32x4{0.f, 0.f, 0.f, 0.f};
#pragma unroll
      for (int ks = 0; ks < 3; ++ks) {
        bf16x8 a = *(const bf16x8*)(smem + (kf * 16 + fr) * KROW + ks * 64 + fq * 16);
        s0[kf][0] = __builtin_amdgcn_mfma_f32_16x16x32_bf16(a, qf[0][ks], s0[kf][0], 0, 0, 0);
        s0[kf][1] = __builtin_amdgcn_mfma_f32_16x16x32_bf16(a, qf[1][ks], s0[kf][1], 0, 0, 0);
      }
    }
#pragma unroll
    for (int qt = 0; qt < 2; ++qt) {
      float mx = -1e30f;
#pragma unroll
      for (int kf = 0; kf < 8; ++kf) mx = fmaxf(fmaxf(fmaxf(s0[kf][qt][0], s0[kf][qt][1]), fmaxf(s0[kf][qt][2], s0[kf][qt][3])), mx);
      mx = fmaxf(mx, shx(mx, 16, lane));
      mx = fmaxf(mx, shx(mx, 32, lane));
      negm[qt] = f32x4{-mx, -mx, -mx, -mx};
    }
  }
  f32x4 lacc[2] = {f32x4{0.f, 0.f, 0.f, 0.f}, f32x4{0.f, 0.f, 0.f, 0.f}};
  const bf16x8 ones = {0x3F80, 0x3F80, 0x3F80, 0x3F80, 0x3F80, 0x3F80, 0x3F80, 0x3F80};
  for (int t = 0; t < nt; ++t) {
    if (t + 1 < nt) {
#pragma unroll
      for (int i = 0; i < 3; ++i) kr[i] = *(const u32x4*)(Kg + (long)(t + 1) * 128 * 96 + (long)(i * 512 + tid) * 8);
#pragma unroll
      for (int i = 0; i < 2; ++i) vr[i] = *(const u32x4*)(Vg + (t + 1) * 128 + voffg[i]);
    }
    const char* kb = smem + (t & 1) * ASTG;
    const char* vb = kb + KBYTES;
#pragma unroll
    for (int hh = 0; hh < 2; ++hh) {
      f32x4 s[4][2];
#pragma unroll
      for (int kf = 0; kf < 4; ++kf) {
#pragma unroll
        for (int ks = 0; ks < 3; ++ks) {
          bf16x8 a = *(const bf16x8*)(kb + (hh * 64 + kf * 16 + fr) * KROW + ks * 64 + fq * 16);
          s[kf][0] = __builtin_amdgcn_mfma_f32_16x16x32_bf16(a, qf[0][ks], ks == 0 ? negm[0] : s[kf][0], 0, 0, 0);
          s[kf][1] = __builtin_amdgcn_mfma_f32_16x16x32_bf16(a, qf[1][ks], ks == 0 ? negm[1] : s[kf][1], 0, 0, 0);
        }
      }
#pragma unroll
      for (int kk = 0; kk < 2; ++kk) {
        bf16x8 pb[2];
#pragma unroll
        for (int qt = 0; qt < 2; ++qt) {
          const float e0 = ex2(s[2 * kk][qt][0]), e1 = ex2(s[2 * kk][qt][1]), e2 = ex2(s[2 * kk][qt][2]), e3 = ex2(s[2 * kk][qt][3]);
          const float e4 = ex2(s[2 * kk + 1][qt][0]), e5 = ex2(s[2 * kk + 1][qt][1]), e6 = ex2(s[2 * kk + 1][qt][2]), e7 = ex2(s[2 * kk + 1][qt][3]);
          u32x4 cw = {pack2(e0, e1), pack2(e2, e3), pack2(e4, e5), pack2(e6, e7)};
          pb[qt] = __builtin_bit_cast(bf16x8, cw);
        }
        lacc[0] = __builtin_amdgcn_mfma_f32_16x16x32_bf16(ones, pb[0], lacc[0], 0, 0, 0);
        lacc[1] = __builtin_amdgcn_mfma_f32_16x16x32_bf16(ones, pb[1], lacc[1], 0, 0, 0);
#pragma unroll
        for (int dvf = 0; dvf < 4; ++dvf) {
          const char* vp = vb + (dvf * 16 + fr) * VROW + (hh * 64 + kk * 32 + fq * 4) * 2;
          const uint2 h0 = *(const uint2*)vp, h1 = *(const uint2*)(vp + 32);
          u32x4 vw = {h0.x, h0.y, h1.x, h1.y};
          const bf16x8 va = __builtin_bit_cast(bf16x8, vw);
          o[dvf][0] = __builtin_amdgcn_mfma_f32_16x16x32_bf16(va, pb[0], o[dvf][0], 0, 0, 0);
          o[dvf][1] = __builtin_amdgcn_mfma_f32_16x16x32_bf16(va, pb[1], o[dvf][1], 0, 0, 0);
        }
      }
    }
    if (t + 1 < nt) {
      char* nb = smem + ((t + 1) & 1) * ASTG;
#pragma unroll
      for (int i = 0; i < 3; ++i) *(u32x4*)(nb + koff[i]) = kr[i];
#pragma unroll
      for (int i = 0; i < 2; ++i) *(u32x4*)(nb + KBYTES + voffl[i]) = vr[i];
    }
    __syncthreads();
  }
#pragma unroll
  for (int qt = 0; qt < 2; ++qt) {
    const float linv = rcpf(lacc[qt][0]);
    const int j = q0 + wid * 32 + qt * 16 + fr;
    const long r = (long)bl * NTOK + j;
#pragma unroll
    for (int dvf = 0; dvf < 4; ++dvf) {
      const int col = head * 64 + dvf * 16 + fq * 4;
      uint2 gz = *(const uint2*)(p.z + r * NINP + C_GMLA + col);
      uint2 ov;
      ov.x = pack2(o[dvf][qt][0] * linv * bflo(gz.x), o[dvf][qt][1] * linv * bfhi(gz.x));
      ov.y = pack2(o[dvf][qt][2] * linv * bflo(gz.y), o[dvf][qt][3] * linv * bfhi(gz.y));
      *(uint2*)(p.Y + r * 512 + col) = ov;
    }
  }
}

DEV void conv_item(const Params& p, int l, int item, int tid) {
  const int tok0 = item * 16;
  const int bl = tok0 / NTOK, jt = tok0 % NTOK;
  const int lo = jt < NCTX ? 0 : NCTX, hi = jt < NCTX ? NCTX : NTOK;
  const int ch0 = (tid & 63) * 8, tr = tid >> 6;
  const int jb = jt + tr * 2;
  const u16* zb = p.z + (long)bl * NTOK * NINP;
  uint4 xa[4], xc[4], bq[2], gq[2];
#pragma unroll
  for (int i = 0; i < 4; ++i) {
    const int j = jb - 1 + i;
    const bool ok = j >= lo && j < hi;
    const int jc = ok ? j : jb;
    xa[i] = *(const uint4*)(zb + (long)jc * NINP + C_CX + ch0);
    xc[i] = *(const uint4*)(zb + (long)jc * NINP + C_CC + ch0);
    if (!ok) xa[i] = make_uint4(0u, 0u, 0u, 0u);
  }
#pragma unroll
  for (int i = 0; i < 2; ++i) {
    bq[i] = *(const uint4*)(zb + (long)(jb + i) * NINP + C_CB + ch0);
    gq[i] = *(const uint4*)(zb + (long)(jb + i) * NINP + C_GCV + ch0);
  }
  float w0[8], w1[8], w2[8], bb[8];
#pragma unroll
  for (int i = 0; i < 8; ++i) {
    w0[i] = p.conv_w[(l * 3 + 0) * 512 + ch0 + i];
    w1[i] = p.conv_w[(l * 3 + 1) * 512 + ch0 + i];
    w2[i] = p.conv_w[(l * 3 + 2) * 512 + ch0 + i];
    bb[i] = p.conv_b[l * 512 + ch0 + i];
  }
  float u[4][8];
#pragma unroll
  for (int i = 0; i < 4; ++i) {
    u[i][0] = bflo(xa[i].x) * bflo(xc[i].x); u[i][1] = bfhi(xa[i].x) * bfhi(xc[i].x);
    u[i][2] = bflo(xa[i].y) * bflo(xc[i].y); u[i][3] = bfhi(xa[i].y) * bfhi(xc[i].y);
    u[i][4] = bflo(xa[i].z) * bflo(xc[i].z); u[i][5] = bfhi(xa[i].z) * bfhi(xc[i].z);
    u[i][6] = bflo(xa[i].w) * bflo(xc[i].w); u[i][7] = bfhi(xa[i].w) * bfhi(xc[i].w);
  }
#pragma unroll
  for (int i = 0; i < 2; ++i) {
    const uint4 b = bq[i], gg = gq[i];
    const float bv[8] = {bflo(b.x), bfhi(b.x), bflo(b.y), bfhi(b.y), bflo(b.z), bfhi(b.z), bflo(b.w), bfhi(b.w)};
    const float gv[8] = {bflo(gg.x), bfhi(gg.x), bflo(gg.y), bfhi(gg.y), bflo(gg.z), bfhi(gg.z), bflo(gg.w), bfhi(gg.w)};
    float y[8];
#pragma unroll
    for (int k = 0; k < 8; ++k) y[k] = bv[k] * (u[i][k] * w0[k] + u[i + 1][k] * w1[k] + u[i + 2][k] * w2[k] + bb[k]) * gv[k];
    uint4 ov;
    ov.x = pack2(y[0], y[1]); ov.y = pack2(y[2], y[3]); ov.z = pack2(y[4], y[5]); ov.w = pack2(y[6], y[7]);
    *(uint4*)(p.Y + ((long)2 * TG + (long)bl * NTOK + jb + i) * 512 + ch0) = ov;
  }
}

constexpr int HROW = 144;
constexpr int H_QH = 0, H_QL = 18432, H_KH = 36864, H_KL = 55296, H_VT = 73728, H_TOT = 82944, H_REF = 84992, H_XCH = 86016;

DEV void split2(float x, u16& hi, u16& lo) {
  hi = f2bf(x);
  lo = f2bf(x - bf2f(hi));
}
DEV void split_pack(float a, float b, unsigned& hi, unsigned& lo) {
  u16 ah, al, bh, bl_;
  split2(a, ah, al);
  split2(b, bh, bl_);
  hi = (unsigned)ah | ((unsigned)bh << 16);
  lo = (unsigned)al | ((unsigned)bl_ << 16);
}
#define MFMA16(a, b, c) __builtin_amdgcn_mfma_f32_16x16x32_bf16(a, b, c, 0, 0, 0)

DEV const u16* hg_zb(const Params& p, int item) {
  const int jseg = item % NSEG, bh = item / NSEG, head = bh & 7, bl = bh >> 3;
  return p.z + ((long)bl * NTOK + jseg * 64) * NINP + head * 64;
}
DEV void hg_load_k(const u16* __restrict__ zb, int tid, u16 (&kr)[16]) {
  const int wid = tid >> 6, lane = tid & 63, dir = wid >> 2, qu = wid & 3;
  const u16* kp = zb + (long)(qu * 16) * NINP + C_HF + dir * 512 + lane;
#pragma unroll
  for (int i = 0; i < 16; ++i) kr[i] = kp[(long)i * NINP];
}
DEV void hg_load_v(const u16* __restrict__ zb, int wid, int lane, u16 (&vr)[8]) {
  const u16* vp = zb + (long)(wid * 8) * NINP + C_HI + lane;
#pragma unroll
  for (int i = 0; i < 8; ++i) vr[i] = vp[(long)i * NINP];
}
DEV void hg_store_vt(int wid, int lane, char* smem, const u16 (&vr)[8]) {
  u32x4 w = {(unsigned)vr[0] | ((unsigned)vr[1] << 16), (unsigned)vr[2] | ((unsigned)vr[3] << 16),
             (unsigned)vr[4] | ((unsigned)vr[5] << 16), (unsigned)vr[6] | ((unsigned)vr[7] << 16)};
  *(u32x4*)(smem + H_VT + lane * HROW + wid * 16) = w;
}
DEV void hg_prep(int dir, int qu, int lane, char* smem, const u16 (&kr)[16], float (&g)[16], float (&kk)[16]) {
#pragma unroll
  for (int i = 0; i < 16; ++i) {
    kk[i] = bf2f(kr[i]);
    g[i] = fmaxf(__logf(1.f - kk[i]), -20.f);
  }
  float total;
  if (dir == 0) {
#pragma unroll
    for (int i = 1; i < 16; ++i) g[i] += g[i - 1];
    total = g[15];
  } else {
#pragma unroll
    for (int i = 14; i >= 0; --i) g[i] += g[i + 1];
    total = g[0];
  }
  ((float*)(smem + H_TOT))[(dir * 4 + qu) * 64 + lane] = total;
}

DEV void hg1_item(const Params& p, int item, char* smem, int tid, const u16 (&kr)[16]) {
  const int wid = tid >> 6, lane = tid & 63, fr = lane & 15, fq = lane >> 4;
  const int jseg = item % NSEG, bh = item / NSEG, head = bh & 7, bl = bh >> 3;
  const int dir = wid >> 2, qu = wid & 3;
  const long row0 = (long)bl * NTOK + jseg * 64;
  const u16* zb = p.z + row0 * NINP + head * 64;
  u16 vr[8];
  hg_load_v(zb, wid, lane, vr);
  float g[16], kk[16];
  __syncthreads();
  hg_prep(dir, qu, lane, smem, kr, g, kk);
  __syncthreads();
  hg_store_vt(wid, lane, smem, vr);
  const float* tot = (const float*)(smem + H_TOT) + dir * 256 + lane;
  const float t0 = tot[0], t1 = tot[64], t2 = tot[128], t3 = tot[192];
  const float T = (t0 + t1) + (t2 + t3);
  float off;
  if (dir == 0) off = (qu > 0 ? t0 : 0.f) + (qu > 1 ? t1 : 0.f) + (qu > 2 ? t2 : 0.f);
  else off = (qu < 3 ? t3 : 0.f) + (qu < 2 ? t2 : 0.f) + (qu < 1 ? t1 : 0.f);
  unsigned wh[8];
#pragma unroll
  for (int i = 0; i < 8; ++i)
    wh[i] = pack2(kk[2 * i] * __expf(T - (g[2 * i] + off)), kk[2 * i + 1] * __expf(T - (g[2 * i + 1] + off)));
  char* khT = smem + H_KH + dir * 9216 + lane * HROW + qu * 32;
  *(u32x4*)khT = u32x4{wh[0], wh[1], wh[2], wh[3]};
  *(u32x4*)(khT + 16) = u32x4{wh[4], wh[5], wh[6], wh[7]};
  const int sidx = dir ? (jseg < 4 ? 3 - jseg : 39 - jseg) : jseg;
  const long slot = ((long)((bl * 8 + head) * 2 + dir)) * NSEG + sidx;
  if (qu == 0) p.Dseg[slot * 64 + lane] = __expf(T);
  __syncthreads();
  f32x4 acc[4];
#pragma unroll
  for (int vt = 0; vt < 4; ++vt) acc[vt] = f32x4{0.f, 0.f, 0.f, 0.f};
#pragma unroll
  for (int ks = 0; ks < 2; ++ks) {
    const int ao = dir * 9216 + (qu * 16 + fr) * HROW + ks * 64 + fq * 16;
    const bf16x8 ah = *(const bf16x8*)(smem + H_KH + ao);
#pragma unroll
    for (int vt = 0; vt < 4; ++vt) {
      const bf16x8 b = *(const bf16x8*)(smem + H_VT + (vt * 16 + fr) * HROW + ks * 64 + fq * 16);
      acc[vt] = MFMA16(ah, b, acc[vt]);
    }
  }
  u16* so = p.Sloc + slot * 4096;
#pragma unroll
  for (int vt = 0; vt < 4; ++vt) {
    uint2 o2;
    o2.x = pack2(acc[vt][0], acc[vt][1]);
    o2.y = pack2(acc[vt][2], acc[vt][3]);
    *(uint2*)(so + (vt * 16 + fr) * 64 + qu * 16 + fq * 4) = o2;
  }
}

DEV void hg3_item(const Params& p, int l, int item, char* smem, int tid, const u16 (&kr)[16]) {
  constexpr int O_QA = 0, O_KA = 18432, O_X = 36864;
  const int wid = tid >> 6, lane = tid & 63, fr = lane & 15, fq = lane >> 4;
  const int jseg = item % NSEG, bh = item / NSEG, head = bh & 7, bl = bh >> 3;
  const int dir = wid >> 2, qu = wid & 3;
  const long row0 = (long)bl * NTOK + jseg * 64;
  const u16* zb = p.z + row0 * NINP + head * 64;
  const int sidx = dir ? (jseg < 4 ? 3 - jseg : 39 - jseg) : jseg;
  const int hf = dir == 0 ? (qu >> 1) : 1 - (qu >> 1);
  u16 vr[8], qr[16];
  hg_load_v(zb, wid, lane, vr);
  {
    const u16* qp = zb + (long)(qu * 16) * NINP + C_HQ + lane;
#pragma unroll
    for (int i = 0; i < 16; ++i) qr[i] = qp[(long)i * NINP];
  }
  u32x4 sf[2][4];
  if (sidx > 0) {
    const u16* sp = p.Sloc + (((long)((bl * 8 + head) * 2 + dir)) * NSEG + sidx - 1) * 4096;
#pragma unroll
    for (int ks = 0; ks < 2; ++ks)
#pragma unroll
      for (int vt = 0; vt < 4; ++vt) sf[ks][vt] = *(const u32x4*)(sp + (vt * 16 + fr) * 64 + ks * 32 + fq * 8);
  }
  const long rfin = row0 + qu * 16 + fr;
  uint2 gz[4];
  if (dir == 0) {
#pragma unroll
    for (int vt = 0; vt < 4; ++vt) gz[vt] = *(const uint2*)(p.z + rfin * NINP + C_GHG + head * 64 + vt * 16 + fq * 4);
  }
  float g[16], kk[16];
  __syncthreads();
  hg_prep(dir, qu, lane, smem, kr, g, kk);
  __syncthreads();
  hg_store_vt(wid, lane, smem, vr);
  {
    const float* tot = (const float*)(smem + H_TOT) + dir * 256 + lane;
    const float t0 = tot[0], t1 = tot[64], t2 = tot[128], t3 = tot[192];
    float off, mA, mA0, Bv;
    if (dir == 0) {
      off = (qu > 0 ? t0 : 0.f) + (qu > 1 ? t1 : 0.f) + (qu > 2 ? t2 : 0.f);
      mA0 = t0; Bv = t0 + t1; mA = hf ? (Bv + t2) : mA0;
    } else {
      off = (qu < 3 ? t3 : 0.f) + (qu < 2 ? t2 : 0.f) + (qu < 1 ? t1 : 0.f);
      mA0 = t3; Bv = t3 + t2; mA = hf ? (Bv + t1) : mA0;
    }
    if (qu == 0) {
      ((float*)(smem + H_REF))[dir * 128 + lane] = __expf(mA0);
      ((float*)(smem + H_REF))[dir * 128 + 64 + lane] = __expf(Bv);
    }
    const int ro = dir * 9216 + (qu * 16) * HROW + lane * 2;
#pragma unroll
    for (int i = 0; i < 16; ++i) {
      const float bb = g[i] + off;
      const float e1 = fminf(fmaxf(bb - mA, -60.f), 60.f);
      const float qv = bf2f(qr[i]);
      *(u16*)(smem + O_QA + ro + i * HROW) = f2bf(qv * __expf(e1));
      *(u16*)(smem + O_KA + ro + i * HROW) = f2bf(kk[i] * __expf(-e1));
      const float xv = hf ? qv * __expf(fminf(bb - Bv, 0.f)) : kk[i] * __expf(fminf(Bv - bb, 0.f));
      *(u16*)(smem + O_X + ro + i * HROW) = f2bf(xv);
    }
  }
  __syncthreads();
  const int tt = qu;
  bf16x8 qA[2], qB[2];
#pragma unroll
  for (int ks = 0; ks < 2; ++ks) {
    const int qo = dir * 9216 + (tt * 16 + fr) * HROW + ks * 64 + fq * 16;
    qA[ks] = *(const bf16x8*)(smem + O_QA + qo);
    qB[ks] = *(const bf16x8*)(smem + O_X + qo);
  }
  f32x4 at[4];
#pragma unroll
  for (int st = 0; st < 4; ++st) {
    at[st] = f32x4{0.f, 0.f, 0.f, 0.f};
    const bool needed = dir == 0 ? (st <= tt) : (st >= tt);
    if (needed) {
      const bool same = (st >> 1) == (tt >> 1);
#pragma unroll
      for (int ks = 0; ks < 2; ++ks) {
        const int ko = dir * 9216 + (st * 16 + fr) * HROW + ks * 64 + fq * 16;
        if (same) at[st] = MFMA16(*(const bf16x8*)(smem + O_KA + ko), qA[ks], at[st]);
        else at[st] = MFMA16(*(const bf16x8*)(smem + O_X + ko), qB[ks], at[st]);
      }
      if (st == tt) {
#pragma unroll
        for (int j = 0; j < 4; ++j) {
          const int sl = fq * 4 + j;
          const bool keep = dir == 0 ? (sl <= fr) : (sl >= fr);
          at[st][j] = keep ? at[st][j] : 0.f;
        }
      }
    }
  }
  f32x4 o[4];
#pragma unroll
  for (int vt = 0; vt < 4; ++vt) o[vt] = f32x4{0.f, 0.f, 0.f, 0.f};
#pragma unroll
  for (int k2 = 0; k2 < 2; ++k2) {
    const u32x4 cw = {pack2(at[2 * k2][0], at[2 * k2][1]), pack2(at[2 * k2][2], at[2 * k2][3]),
                      pack2(at[2 * k2 + 1][0], at[2 * k2 + 1][1]), pack2(at[2 * k2 + 1][2], at[2 * k2 + 1][3])};
    const bf16x8 pb = __builtin_bit_cast(bf16x8, cw);
#pragma unroll
    for (int vt = 0; vt < 4; ++vt) {
      const char* vp = smem + H_VT + (vt * 16 + fr) * HROW + (k2 * 32 + fq * 4) * 2;
      const uint2 h0 = *(const uint2*)vp, h1 = *(const uint2*)(vp + 32);
      const u32x4 vw = {h0.x, h0.y, h1.x, h1.y};
      o[vt] = MFMA16(__builtin_bit_cast(bf16x8, vw), pb, o[vt]);
    }
  }
  if (sidx > 0) {
    const float* rf = (const float*)(smem + H_REF) + dir * 128 + hf * 64;
#pragma unroll
    for (int ks = 0; ks < 2; ++ks) {
      const float4 e0 = *(const float4*)(rf + ks * 32 + fq * 8), e1 = *(const float4*)(rf + ks * 32 + fq * 8 + 4);
      const bf16x8 qi = hf ? qB[ks] : qA[ks];
#pragma unroll
      for (int vt = 0; vt < 4; ++vt) {
        const u32x4 sv = sf[ks][vt];
        const u32x4 sw = {pack2(bflo(sv[0]) * e0.x, bfhi(sv[0]) * e0.y), pack2(bflo(sv[1]) * e0.z, bfhi(sv[1]) * e0.w),
                          pack2(bflo(sv[2]) * e1.x, bfhi(sv[2]) * e1.y), pack2(bflo(sv[3]) * e1.z, bfhi(sv[3]) * e1.w)};
        o[vt] = MFMA16(__builtin_bit_cast(bf16x8, sw), qi, o[vt]);
      }
    }
  }
  f32x4* xch = (f32x4*)(smem + H_XCH);
  if (dir == 1) {
#pragma unroll
    for (int vt = 0; vt < 4; ++vt) xch[(tt * 4 + vt) * 64 + lane] = o[vt];
  }
  __syncthreads();
  if (dir == 0) {
    float ss = 0.f;
#pragma unroll
    for (int vt = 0; vt < 4; ++vt) {
      o[vt] += xch[(tt * 4 + vt) * 64 + lane];
      ss += o[vt][0] * o[vt][0] + o[vt][1] * o[vt][1] + o[vt][2] * o[vt][2] + o[vt][3] * o[vt][3];
    }
    ss += shx(ss, 16, lane);
    ss += shx(ss, 32, lane);
    const float rstd = rsqrtf(ss * (1.f / 64.f) + 1e-6f);
#pragma unroll
    for (int vt = 0; vt < 4; ++vt) {
      const int col = head * 64 + vt * 16 + fq * 4;
      const float4 gn = *(const float4*)(p.hg_norm_g + l * 512 + col);
      uint2 ov;
      ov.x = pack2(o[vt][0] * rstd * gn.x * bflo(gz[vt].x), o[vt][1] * rstd * gn.y * bfhi(gz[vt].x));
      ov.y = pack2(o[vt][2] * rstd * gn.z * bflo(gz[vt].y), o[vt][3] * rstd * gn.w * bfhi(gz[vt].y));
      *(uint2*)(p.Y + ((long)TG + rfin) * 512 + col) = ov;
    }
  }
}

template <int WT>
DEV void branch_item(const Params& p, int l, int t0, int tf, char* smem, int tid) {
  const int f0 = tf * 128;
  const int wid = tid >> 6, lane = tid & 63, fr = lane & 15, fq = lane >> 4, wn = wid & 3, wt = wid >> 2;
  f32x4 mg[2][WT];
  zero_acc<2, WT>(mg);
#pragma nounroll
  for (int br = 0; br < 3; ++br) {
    f32x4 acc[2][WT];
    zero_acc<2, WT>(acc);
    constexpr bool PREG = (WT <= 6);
    uint2 gzr[2][PREG ? WT : 1];
    if (PREG) {
#pragma unroll
      for (int n = 0; n < 2; ++n)
#pragma unroll
        for (int t = 0; t < (PREG ? WT : 1); ++t)
          gzr[n][t] = *(const uint2*)(p.z + (long)(t0 + wt * (WT * 16) + t * 16 + fr) * NINP + C_BRG + br * 1024 + f0 + wn * 32 + n * 16 + fq * 4);
    }
    gemm_mainloop<2, WT>(p.WbrT + ((long)(l * 3 + br) * 1024 + f0) * 512, 512, p.Y + ((long)br * TG + t0) * 512, 512, 512, smem, tid, acc);
#pragma unroll
    for (int n = 0; n < 2; ++n) {
#pragma unroll
      for (int t = 0; t < WT; ++t) {
        const uint2 gz = PREG ? gzr[n][PREG ? t : 0]
                              : *(const uint2*)(p.z + (long)(t0 + wt * (WT * 16) + t * 16 + fr) * NINP + C_BRG + br * 1024 + f0 + wn * 32 + n * 16 + fq * 4);
        mg[n][t][0] += bflo(gz.x) * acc[n][t][0];
        mg[n][t][1] += bfhi(gz.x) * acc[n][t][1];
        mg[n][t][2] += bflo(gz.y) * acc[n][t][2];
        mg[n][t][3] += bfhi(gz.y) * acc[n][t][3];
      }
    }
  }
#pragma unroll
  for (int n = 0; n < 2; ++n) {
    const int f = f0 + wn * 32 + n * 16 + fq * 4;
#pragma unroll
    for (int t = 0; t < WT; ++t) {
      const long r = t0 + wt * (WT * 16) + t * 16 + fr;
      uint2 o;
      o.x = pack2(mg[n][t][0], mg[n][t][1]);
      o.y = pack2(mg[n][t][2], mg[n][t][3]);
      *(uint2*)(p.mg + r * 1024 + f) = o;
    }
  }
}

template <int WT>
DEV void outproj_item(const Params& p, int l, int g, int t0, int tf, char* smem, int tid) {
  const int f0 = tf * 128;
  const int wid = tid >> 6, lane = tid & 63, fr = lane & 15, fq = lane >> 4, wn = wid & 3, wt = wid >> 2;
  f32x4 acc[2][WT];
  zero_acc<2, WT>(acc);
  const int bl = t0 / NTOK, j0 = t0 % NTOK, b = g * G + bl;
  const float* gate_c = p.mod + ((long)l * 33 + 32) * 3072 + 2048;
  const float* gate_l = p.mod + ((long)l * 33 + b) * 3072 + 2048;
  const float* hc = (l == 0 ? p.ctx : p.hctx) + (long)b * NCTX * D;
  const float* hl = (l == 0 ? p.x : p.out) + (long)b * SEQ * D;
  float4 hpre[2][WT];
#pragma unroll
  for (int n = 0; n < 2; ++n)
#pragma unroll
    for (int t = 0; t < WT; ++t) {
      const int f = f0 + wn * 32 + n * 16 + fq * 4;
      const int j = j0 + wt * (WT * 16) + t * 16 + fr;
      hpre[n][t] = *(const float4*)(j < NCTX ? hc + (long)j * D + f : hl + (long)(j - NCTX) * D + f);
    }
  gemm_mainloop<2, WT>(p.WoutT + ((long)l * 1024 + f0) * 1024, 1024, p.mg + (long)t0 * 1024, 1024, 1024, smem, tid, acc);
#pragma unroll
  for (int n = 0; n < 2; ++n) {
    const int f = f0 + wn * 32 + n * 16 + fq * 4;
    const float4 gc = *(const float4*)(gate_c + f), gl = *(const float4*)(gate_l + f);
#pragma unroll
    for (int t = 0; t < WT; ++t) {
      const int j = j0 + wt * (WT * 16) + t * 16 + fr;
      const bool isctx = j < NCTX;
      const float4 gt = isctx ? gc : gl;
      float* hd = isctx ? p.hctx + ((long)b * NCTX + j) * D + f : p.out + ((long)b * SEQ + (j - NCTX)) * D + f;
      float4 h = hpre[n][t];
      h.x += gt.x * acc[n][t][0];
      h.y += gt.y * acc[n][t][1];
      h.z += gt.z * acc[n][t][2];
      h.w += gt.w * acc[n][t][3];
      *(float4*)hd = h;
    }
  }
}


#define XB_TMO 128
#define XB_XCNT(j) (256 + 64 * (j))
#define XB_XSUB(j) (1280 + 64 * (j))
#define XB_XGEN(j) (2304 + 64 * (j))
#define XB_TOP 3328
#define XB_TOPGEN 3392
#define XCD_BAR_WORDS 3456
#define XB_SPIN_CAP (1u << 22)
#define LAS __attribute__((address_space(3)))
DEV unsigned xb_ld(unsigned* p) { return __hip_atomic_load(p, __ATOMIC_RELAXED, __HIP_MEMORY_SCOPE_AGENT); }
DEV unsigned xb_add(unsigned* p, unsigned v) { return __hip_atomic_fetch_add(p, v, __ATOMIC_RELAXED, __HIP_MEMORY_SCOPE_AGENT); }
DEV unsigned xb_xcc_id() { return (unsigned)__builtin_amdgcn_s_getreg((3 << 11) | 20) & 0xFu; }
#define XB_SPIN(cond, bar)                                                                   \
  do {                                                                                       \
    unsigned _sp = 0;                                                                        \
    while (cond) {                                                                           \
      __builtin_amdgcn_s_sleep(1);                                                           \
      if ((++_sp & 255u) == 0u) {                                                            \
        if (xb_ld(&(bar)[XB_TMO])) break;                                                    \
        if (_sp > XB_SPIN_CAP) { atomicAdd(&(bar)[XB_TMO], 1u); break; }                     \
      }                                                                                      \
    }                                                                                        \
  } while (0)
struct XcdBarrier {
  unsigned* bar;
  unsigned x;
  volatile LAS unsigned* st;
};
DEV XcdBarrier xcd_barrier_post(unsigned* bar, volatile LAS unsigned* st) {
  XcdBarrier b;
  b.bar = bar;
  b.x = xb_xcc_id();
  b.st = st;
  if (threadIdx.x == 0) (void)xb_add(&bar[XB_XCNT(b.x)], 1u);
  return b;
}
DEV void xcd_barrier_complete(unsigned* bar, unsigned x, unsigned& nloc, unsigned& nx) {
  const unsigned Gn = gridDim.x * gridDim.y * gridDim.z;
  unsigned sum, cnt, mine, sp = 0u;
  for (;;) {
    sum = 0u; cnt = 0u; mine = 0u;
#pragma unroll
    for (unsigned j = 0; j < 16; ++j) {
      const unsigned c = xb_ld(&bar[XB_XCNT(j)]);
      sum += c;
      cnt += (c > 0u) ? 1u : 0u;
      mine = (j == x) ? c : mine;
    }
    if (sum == Gn) break;
    __builtin_amdgcn_s_sleep(1);
    if ((++sp & 255u) == 0u) {
      if (xb_ld(&bar[XB_TMO])) break;
      if (sp > XB_SPIN_CAP) { atomicAdd(&bar[XB_TMO], 1u); break; }
    }
  }
  nloc = mine > 0u ? mine : 1u;
  nx = cnt > 0u ? cnt : 1u;
}
DEV void xcd_barrier(const XcdBarrier& b) {
  asm volatile("s_waitcnt vmcnt(0)" ::: "memory");
  __syncthreads();
  if (threadIdx.x == 0) {
    unsigned* bar = b.bar;
    __builtin_amdgcn_s_waitcnt(0);
    unsigned nloc = b.st[0], nx = b.st[1];
    if (nloc == 0u) { xcd_barrier_complete(bar, b.x, nloc, nx); b.st[0] = nloc; b.st[1] = nx; }
    const unsigned old = xb_add(&bar[XB_XSUB(b.x)], 1u);
    const unsigned gen = old / nloc;
    if (old + 1u == (gen + 1u) * nloc) {
      __builtin_amdgcn_fence(__ATOMIC_RELEASE, "agent");
      asm volatile("s_waitcnt vmcnt(0)" ::: "memory");
      const unsigned og = xb_add(&bar[XB_TOP], 1u);
      const unsigned tg = og / nx;
      if (og + 1u == (tg + 1u) * nx) xb_add(&bar[XB_TOPGEN], 1u);
      else XB_SPIN(xb_ld(&bar[XB_TOPGEN]) == tg, bar);
      __builtin_amdgcn_fence(__ATOMIC_ACQUIRE, "agent");
      xb_add(&bar[XB_XGEN(b.x)], 1u);
      asm volatile("s_waitcnt vmcnt(0)" ::: "memory");
    } else {
      XB_SPIN(xb_ld(&bar[XB_XGEN(b.x)]) == gen, bar);
      __builtin_amdgcn_fence(__ATOMIC_ACQUIRE, "agent");
      asm volatile("s_waitcnt vmcnt(0)" ::: "memory");
    }
  }
  __syncthreads();
}

#define REPS(k) for (int rp = 0; rp < ((PROBE == (k)) ? 2 : 1); ++rp)
#define GSYNC do { xcd_barrier(xb); if (PROBE == 11) xcd_barrier(xb); } while (0)
__global__ void __launch_bounds__(512) mega(Params p, int coop) {
  __shared__ __attribute__((aligned(16))) char smem[147456 + 16];
  cg::grid_group grid = cg::this_grid();
  const int tid0 = threadIdx.x, nb = gridDim.x, bid = blockIdx.x;
  const int xx = bid & 7, xr = bid >> 3, xper = nb >> 3;
  if (tid0 < 4) ((unsigned*)(smem + 147456))[tid0] = 0u;
  __syncthreads();
  XcdBarrier xb = xcd_barrier_post(p.bar, (volatile LAS unsigned*)(smem + 147456));
#define OPQ int tid = tid0; asm volatile("" : "+v"(tid));

  for (int it = bid; it < PRE_ITEMS; it += nb) { OPQ pre_item(p, it, smem, tid); }
  grid.sync();

  for (int g = 0; g < NGRP; ++g) {
    for (int l = 0; l < DEPTH; ++l) {
      const bool last = (l == DEPTH - 1);
      REPS(10) {
        for (int it = bid; it < TG / 8; it += nb) { OPQ norm_item(p, l, g, it, tid); }
        GSYNC;
      }
      REPS(1) {
        {
          const int ntile = last ? 8 * 34 + 8 : 9 * 34;
          auto tile_of = [&](int j, int& tl, int& tf) {
            if (!last) { tl = j % 9; tf = j / 9; }
            else if (j < 8 * 34) { tl = 1 + (j & 7); tf = j >> 3; }
            else { tl = 0; const int q = j - 8 * 34; tf = q == 0 ? 1 : 4 + q; }
          };
          __syncthreads();
          if (xr < ntile) {
            OPQ
            int tl, tf;
            tile_of(xr, tl, tf);
            gemm8_prefetch<1024>(p.WinT + ((long)l * NINP + tf * 256) * 1024, p.u + (long)(xx * 9 + tl) * 256 * 1024, smem, tid);
          }
          for (int j = xr; j < ntile; j += xper) {
            OPQ
            int tl, tf, ntl = 0, ntf = 0;
            tile_of(j, tl, tf);
            const int jn = j + xper;
            const bool hn = jn < ntile;
            if (hn) tile_of(jn, ntl, ntf);
            inproj_item(p, l, xx * 9 + tl, tf, hn ? xx * 9 + ntl : -1, ntf, smem, tid);
          }
        }
        GSYNC;
      }
      REPS(2) {
        {
          OPQ
          u16 kr[16];
          hg_load_k(hg_zb(p, bid), tid, kr);
          for (int it = bid; it < 2304; it += nb) {
            u16 kr2[16];
            const int nxt = (it + nb < 2304) ? it + nb : it;
            hg_load_k(hg_zb(p, nxt), tid, kr2);
            hg1_item(p, it, smem, tid, kr);
#pragma unroll
            for (int i = 0; i < 16; ++i) kr[i] = kr2[i];
          }
        }
        for (int j = xr; j < 72 + 96 + 9; j += xper) {
          OPQ
          if (j < 72) qproj_item(p, l, xx * 12 + j % 12, j / 12, smem, tid);
          else if (j < 168) kvproj_item(p, l, xx * 12 + (j - 72) % 12, (j - 72) / 12, smem, tid);
          else krope_item(p, xx * 9 + (j - 168), tid);
        }
        GSYNC;
      }
      REPS(3) {
        for (int j = xr; j < (last ? 64 : 72); j += xper) {
          OPQ
          if (j < 64) attn_item(p, j >> 3, xx, NCTX + (j & 7) * 256, NTOK, smem, tid);
          else attn_item(p, j - 64, xx, 0, NCTX, smem, tid);
        }
        if (!rp)
          for (int it = bid; it < 512; it += nb) { OPQ hg_combine_item(p, it, tid); }
        GSYNC;
      }
      REPS(4) {
        {
          OPQ
          const int nh3 = last ? G * 8 * 32 : G * 8 * NSEG;
          auto h3map = [&](int it) { return last ? (it >> 5) * NSEG + 4 + (it & 31) : it; };
          u16 kr[16];
          hg_load_k(hg_zb(p, h3map(bid)), tid, kr);
          for (int it = bid; it < nh3; it += nb) {
            u16 kr2[16];
            const int nxt = (it + nb < nh3) ? it + nb : it;
            hg_load_k(hg_zb(p, h3map(nxt)), tid, kr2);
            hg3_item(p, l, h3map(it), smem, tid, kr);
#pragma unroll
            for (int i = 0; i < 16; ++i) kr[i] = kr2[i];
          }
        }
        for (int it = bid; it < (last ? G * (SEQ / 16) : TG / 16); it += nb) {
          OPQ
          conv_item(p, l, last ? (it >> 7) * (NTOK / 16) + (NCTX / 16) + (it & 127) : it, tid);
        }
        GSYNC;
      }
      REPS(5) {
        if (!last) {
          for (int j = xr; j < 96; j += xper) { OPQ branch_item<6>(p, l, (xx * 12 + j % 12) * 192, j / 12, smem, tid); }
        } else {
          for (int j = xr; j < 64; j += xper) { OPQ branch_item<8>(p, l, xx * NTOK + NCTX + (j & 7) * 256, j >> 3, smem, tid); }
        }
        GSYNC;
      }
      if (!last) {
        for (int j = xr; j < 96; j += xper) { OPQ outproj_item<6>(p, l, g, (xx * 12 + j % 12) * 192, j / 12, smem, tid); }
      } else {
        for (int j = xr; j < 64; j += xper) { OPQ outproj_item<8>(p, l, g, xx * NTOK + NCTX + (j & 7) * 256, j >> 3, smem, tid); }
      }
      GSYNC;
    }
    for (int it = bid; it < G * SEQ / 8; it += nb) { OPQ final_norm_item(p, g, it, tid); }
  }
}

extern "C" void kernel_launch(void* const* d_in, const int* in_sizes, int n_in, void* d_out, int out_size,
                              void* d_ws, size_t ws_size, hipStream_t stream) {
  Params p{};
  const float* const* in = (const float* const*)d_in;
  p.x = in[0]; p.c = in[1]; p.ctx = in[2]; p.c_ctx = in[3]; p.ada_w = in[4]; p.ada_b = in[5]; p.norm_g = in[6];
  p.w_in = in[7]; p.q_norm_g = in[8]; p.kv_norm_g = in[9]; p.w_uq = in[10]; p.w_ukv = in[11]; p.lb_logits = in[12];
  p.hg_norm_g = in[13]; p.conv_w = in[14]; p.conv_b = in[15]; p.w_branch = in[16]; p.w_out = in[17]; p.final_g = in[18];
  p.out = (float*)d_out;
  char* w = (char*)d_ws;
  size_t off = 0;
  auto take = [&](size_t bytes) { char* r = w + off; off += (bytes + 255) & ~(size_t)255; return r; };
  p.WinT = (u16*)take((size_t)DEPTH * NINP * 1024 * 2);
  p.WuqT = (u16*)take((size_t)DEPTH * 768 * 256 * 2);
  p.WukvT = (u16*)take((size_t)DEPTH * 1024 * 128 * 2);
  p.WbrT = (u16*)take((size_t)DEPTH * 3 * 1024 * 512 * 2);
  p.WoutT = (u16*)take((size_t)DEPTH * 1024 * 1024 * 2);
  p.mod = (float*)take((size_t)DEPTH * 33 * 3072 * 4);
  p.lb = (float*)take((size_t)DEPTH * 1024 * 4);
  p.rope = (float*)take((size_t)64 * 8 * 2 * 4);
  p.hctx = (float*)take((size_t)NB * NCTX * D * 4);
  p.u = (u16*)take((size_t)TG * D * 2);
  p.z = (u16*)take((size_t)TG * NINP * 2);
  p.Q = (u16*)take((size_t)G * 8 * NTOK * 96 * 2);
  p.Kc = (u16*)take((size_t)G * 8 * NTOK * 96 * 2);
  p.Vt = (u16*)take((size_t)G * 8 * 64 * NTOK * 2);
  p.Y = (u16*)take((size_t)3 * TG * 512 * 2);
  p.mg = (u16*)take((size_t)TG * D * 2);
  p.ob = (float*)take((size_t)TG * 512 * 4);
  p.Sloc = (u16*)take((size_t)G * 16 * NSEG * 4096 * 2);
  p.Dseg = (float*)take((size_t)G * 16 * NSEG * 64 * 4);
  p.bar = (unsigned*)take((size_t)XCD_BAR_WORDS * 4);
  if (off > ws_size) { fprintf(stderr, "workspace too small: need %zu have %zu\n", off, ws_size); return; }

  static int grid_blocks = 0;
  if (!grid_blocks) {
    int dev = 0, cus = 0, per_cu = 0;
    hipGetDevice(&dev);
    hipDeviceGetAttribute(&cus, hipDeviceAttributeMultiprocessorCount, dev);
    hipOccupancyMaxActiveBlocksPerMultiprocessor(&per_cu, mega, 512, 0);
    if (per_cu < 1) per_cu = 1;
    if (per_cu > 1) per_cu = 1;
    grid_blocks = (cus * per_cu) & ~7;
  }
  int coop = 1;
  void* args[] = {&p, &coop};
  if (hipMemsetAsync(p.bar, 0, (size_t)XCD_BAR_WORDS * 4, stream) != hipSuccess) fprintf(stderr, "memset failed\n");
  hipError_t e = hipLaunchCooperativeKernel((void*)mega, dim3(grid_blocks), dim3(512), args, 0, stream);
  if (e != hipSuccess) fprintf(stderr, "cooperative launch failed: %s (grid %d)\n", hipGetErrorString(e), grid_blocks);
}
```
